# Optimizing an MI355X kernel written in HIP

```python
import jax, jax.numpy as jnp
from jax import lax
import numpy as np

D_MODEL = 4096
BATCH = 4
SEQ = 2048
DEPTH = 1

HEAD_DIM = 128
N_FOX_HEADS = D_MODEL // HEAD_DIM // 2
N_SB_HEADS = D_MODEL // HEAD_DIM // 2
N_MIX_HEADS = N_FOX_HEADS + N_SB_HEADS
FOX_W = N_FOX_HEADS * HEAD_DIM
SB_W = N_SB_HEADS * HEAD_DIM
MIX_W = FOX_W + SB_W
N_IN = 4 * FOX_W + N_FOX_HEADS + 3 * SB_W
BLOCK_Q = 128
N_MEM = 256
XA_HEADS = 4
XA_W = XA_HEADS * HEAD_DIM
N_EXPERTS = 32
TOP_K = 4
D_EXPERT = D_MODEL // 4
SWIGLU_LIMIT = 7.0
SWIGLU_ALPHA = 1.702
LN_EPS = 1e-5
RMS_EPS = 1e-6
DEEPNORM_ALPHA = (2 * DEPTH) ** 0.25
DEEPNORM_BETA = (8 * DEPTH) ** -0.25

kernel_name = 'hybrid_fox_stickbreak_moe_block'


def layer_norm(x, g, b):
    xf = x.astype(jnp.float32)
    mu = jnp.mean(xf, axis=-1, keepdims=True)
    var = jnp.mean(jnp.square(xf - mu), axis=-1, keepdims=True)
    return ((xf - mu) * lax.rsqrt(var + LN_EPS)).astype(x.dtype) * g + b


def rms_norm(x, g):
    xf = x.astype(jnp.float32)
    y = xf * lax.rsqrt(jnp.mean(jnp.square(xf), axis=-1, keepdims=True) + RMS_EPS)
    return y.astype(x.dtype) * g


def forgetting_attention(q, k, v, c):
    S = q.shape[2]
    scale = HEAD_DIM ** -0.5
    outs = []
    for i in range(S // BLOCK_Q):
        q0 = i * BLOCK_Q
        q1 = q0 + BLOCK_Q
        s = jnp.einsum('bhqd,bhkd->bhqk', q[:, :, q0:q1], k[:, :, :q1]).astype(jnp.float32) * scale
        s = s + c[:, :, q0:q1, None] - c[:, :, None, :q1]
        qpos = q0 + jnp.arange(BLOCK_Q)
        kpos = jnp.arange(q1)
        s = jnp.where(kpos[None, :] <= qpos[:, None], s, -jnp.inf)
        p = jax.nn.softmax(s, axis=-1).astype(v.dtype)
        outs.append(jnp.einsum('bhqk,bhkd->bhqd', p, v[:, :, :q1]))
    return jnp.concatenate(outs, axis=2)


def stick_breaking_attention(q, k, v):
    S = q.shape[2]
    scale = HEAD_DIM ** -0.5
    outs = []
    for i in range(S // BLOCK_Q):
        q0 = i * BLOCK_Q
        q1 = q0 + BLOCK_Q
        z = jnp.einsum('bhqd,bhkd->bhqk', q[:, :, q0:q1], k[:, :, :q1]).astype(jnp.float32) * scale
        qpos = q0 + jnp.arange(BLOCK_Q)
        kpos = jnp.arange(q1)
        strict = kpos[None, :] < qpos[:, None]
        log_1m = jnp.where(strict, jax.nn.log_sigmoid(-z), 0.0)
        tail = lax.cumsum(log_1m, axis=3, reverse=True) - log_1m
        a = jnp.where(strict, jnp.exp(jax.nn.log_sigmoid(z) + tail), 0.0)
        outs.append(jnp.einsum('bhqk,bhkd->bhqd', a.astype(v.dtype), v[:, :, :q1]))
    return jnp.concatenate(outs, axis=2)


def hybrid_mixer(h, w_in, b_f, fox_q_norm_g, fox_k_norm_g, mix_norm_g, w_out):
    B, S, _ = h.shape
    p = h @ w_in

    def heads(lo, n):
        return p[..., lo:lo + n * HEAD_DIM].reshape(B, S, n, HEAD_DIM)

    q_f = heads(0, N_FOX_HEADS)
    k_f = heads(FOX_W, N_FOX_HEADS)
    v_f = heads(2 * FOX_W, N_FOX_HEADS)
    g_f = heads(3 * FOX_W, N_FOX_HEADS)
    f_logit = p[..., 4 * FOX_W:4 * FOX_W + N_FOX_HEADS]
    sb0 = 4 * FOX_W + N_FOX_HEADS
    q_s = heads(sb0, N_SB_HEADS)
    k_s = heads(sb0 + SB_W, N_SB_HEADS)
    v_s = heads(sb0 + 2 * SB_W, N_SB_HEADS)

    q_f = rms_norm(q_f, fox_q_norm_g)
    k_f = rms_norm(k_f, fox_k_norm_g)
    log_f = jax.nn.log_sigmoid(f_logit.astype(jnp.float32) + b_f)
    c = jnp.cumsum(log_f, axis=1).transpose(0, 2, 1)

    def bhsd(t):
        return t.transpose(0, 2, 1, 3)

    o_f = bhsd(forgetting_attention(bhsd(q_f), bhsd(k_f), bhsd(v_f), c))
    o_s = bhsd(stick_breaking_attention(bhsd(q_s), bhsd(k_s), bhsd(v_s)))
    o_f = rms_norm(o_f, mix_norm_g[:N_FOX_HEADS]) * jax.nn.sigmoid(g_f)
    o_s = rms_norm(o_s, mix_norm_g[N_FOX_HEADS:])
    o = jnp.concatenate([o_f, o_s], axis=2).reshape(B, S, MIX_W)
    return o @ w_out


def memory_cross_attention(h, mem_n, wq, wkv, wo):
    B, S, _ = h.shape
    M = mem_n.shape[1]
    q = (h @ wq).reshape(B, S, XA_HEADS, HEAD_DIM)
    kv = mem_n @ wkv
    k = kv[..., :XA_W].reshape(B, M, XA_HEADS, HEAD_DIM)
    v = kv[..., XA_W:].reshape(B, M, XA_HEADS, HEAD_DIM)
    s = jnp.einsum('bshd,bmhd->bhsm', q, k).astype(jnp.float32) * HEAD_DIM ** -0.5
    pr = jax.nn.softmax(s, axis=-1).astype(v.dtype)
    o = jnp.einsum('bhsm,bmhd->bshd', pr, v).reshape(B, S, XA_W)
    return o @ wo


def clamped_swiglu_moe(h, router_w, router_b, w_up, b_up, w_down, b_down):
    B, S, D = h.shape
    T = B * S
    ht = h.reshape(T, D)
    logits = (ht @ router_w + router_b).astype(jnp.float32)
    top_v, top_i = lax.top_k(logits, TOP_K)
    top_w = jax.nn.softmax(top_v, axis=-1)
    gate = jnp.sum(jax.nn.one_hot(top_i, N_EXPERTS, dtype=jnp.float32) * top_w[..., None],
                   axis=1).astype(h.dtype)
    out = jnp.zeros_like(ht)
    for e in range(N_EXPERTS):
        gu = ht @ w_up[e] + b_up[e]
        g = jnp.minimum(gu[:, :D_EXPERT], SWIGLU_LIMIT)
        u = jnp.clip(gu[:, D_EXPERT:], -SWIGLU_LIMIT, SWIGLU_LIMIT)
        a = (u + 1.0) * g * jax.nn.sigmoid(SWIGLU_ALPHA * g)
        out = out + gate[:, e:e + 1] * (a @ w_down[e] + b_down[e])
    return out.reshape(B, S, D)


def setup_inputs(seed: int = 0) -> dict:
    key = jax.random.key(seed)
    keys = jax.random.split(key, 48)
    counter = iter(range(48))
    L = DEPTH
    beta = DEEPNORM_BETA
    s_d = D_MODEL ** -0.5

    def normal(shape, scale):
        return jax.random.normal(keys[next(counter)], shape, jnp.float32) * scale

    def gain(shape):
        return 1.0 + normal(shape, 0.02)

    x = normal((BATCH, SEQ, D_MODEL), 1.0)
    mem = normal((BATCH, N_MEM, D_MODEL), 1.0)
    ln_in_g = gain((D_MODEL,))
    ln_in_b = normal((D_MODEL,), 0.02)
    w_in = jnp.concatenate([
        normal((L, D_MODEL, 2 * FOX_W), s_d),
        normal((L, D_MODEL, FOX_W), s_d * beta),
        normal((L, D_MODEL, FOX_W), s_d),
        normal((L, D_MODEL, N_FOX_HEADS), s_d),
        normal((L, D_MODEL, 2 * SB_W), s_d),
        normal((L, D_MODEL, SB_W), s_d * beta),
    ], axis=-1)
    b_f = jnp.linspace(1.0, 6.0, N_FOX_HEADS, dtype=jnp.float32)[None, :] + normal((L, N_FOX_HEADS), 0.1)
    fox_q_norm_g = gain((L, HEAD_DIM))
    fox_k_norm_g = gain((L, HEAD_DIM))
    mix_norm_g = gain((L, N_MIX_HEADS, HEAD_DIM))
    w_out = normal((L, MIX_W, D_MODEL), MIX_W ** -0.5 * beta)
    ln_mix_g = gain((L, D_MODEL))
    ln_mix_b = normal((L, D_MODEL), 0.02)
    mem_ln_g = gain((L, D_MODEL))
    mem_ln_b = normal((L, D_MODEL), 0.02)
    xa_wq = normal((L, D_MODEL, XA_W), s_d)
    xa_wkv = jnp.concatenate([normal((L, D_MODEL, XA_W), s_d),
                              normal((L, D_MODEL, XA_W), s_d * beta)], axis=-1)
    xa_wo = normal((L, XA_W, D_MODEL), XA_W ** -0.5 * beta)
    ln_xa_g = gain((L, D_MODEL))
    ln_xa_b = normal((L, D_MODEL), 0.02)
    router_w = normal((L, D_MODEL, N_EXPERTS), s_d)
    router_b = normal((L, N_EXPERTS), 0.01)
    w_up = normal((L, N_EXPERTS, D_MODEL, 2 * D_EXPERT), s_d)
    b_up = normal((L, N_EXPERTS, 2 * D_EXPERT), 0.01)
    w_down = normal((L, N_EXPERTS, D_EXPERT, D_MODEL), D_EXPERT ** -0.5 * beta)
    b_down = normal((L, N_EXPERTS, D_MODEL), 0.01)
    ln_moe_g = gain((L, D_MODEL))
    ln_moe_b = normal((L, D_MODEL), 0.02)
    return {'x': x, 'mem': mem, 'ln_in_g': ln_in_g, 'ln_in_b': ln_in_b,
            'w_in': w_in, 'b_f': b_f, 'fox_q_norm_g': fox_q_norm_g, 'fox_k_norm_g': fox_k_norm_g,
            'mix_norm_g': mix_norm_g, 'w_out': w_out, 'ln_mix_g': ln_mix_g, 'ln_mix_b': ln_mix_b,
            'mem_ln_g': mem_ln_g, 'mem_ln_b': mem_ln_b, 'xa_wq': xa_wq, 'xa_wkv': xa_wkv,
            'xa_wo': xa_wo, 'ln_xa_g': ln_xa_g, 'ln_xa_b': ln_xa_b,
            'router_w': router_w, 'router_b': router_b, 'w_up': w_up, 'b_up': b_up,
            'w_down': w_down, 'b_down': b_down, 'ln_moe_g': ln_moe_g, 'ln_moe_b': ln_moe_b}


def reference(x, mem, ln_in_g, ln_in_b, w_in, b_f, fox_q_norm_g, fox_k_norm_g, mix_norm_g,
              w_out, ln_mix_g, ln_mix_b, mem_ln_g, mem_ln_b, xa_wq, xa_wkv, xa_wo,
              ln_xa_g, ln_xa_b, router_w, router_b, w_up, b_up, w_down, b_down,
              ln_moe_g, ln_moe_b):
    h = layer_norm(x, ln_in_g, ln_in_b)
    for l in range(DEPTH):
        mix = hybrid_mixer(h, w_in[l], b_f[l], fox_q_norm_g[l], fox_k_norm_g[l], mix_norm_g[l], w_out[l])
        h = layer_norm(DEEPNORM_ALPHA * h + mix, ln_mix_g[l], ln_mix_b[l])
        mem_n = layer_norm(mem, mem_ln_g[l], mem_ln_b[l])
        xa = memory_cross_attention(h, mem_n, xa_wq[l], xa_wkv[l], xa_wo[l])
        h = layer_norm(DEEPNORM_ALPHA * h + xa, ln_xa_g[l], ln_xa_b[l])
        ff = clamped_swiglu_moe(h, router_w[l], router_b[l], w_up[l], b_up[l], w_down[l], b_down[l])
        h = layer_norm(DEEPNORM_ALPHA * h + ff, ln_moe_g[l], ln_moe_b[l])
    return h
```

```cpp
#include <hip/hip_runtime.h>
#include <cstdio>
#include <cstdint>

#ifndef MK_PER_PHASE
#define MK_PER_PHASE 0
#endif

#define GAS __attribute__((address_space(1)))
#define LAS __attribute__((address_space(3)))
typedef unsigned short bf16;
typedef short bf16x8 __attribute__((ext_vector_type(8)));
typedef short s16x4 __attribute__((ext_vector_type(4)));
typedef float f32x4 __attribute__((ext_vector_type(4)));
typedef float f32x2 __attribute__((ext_vector_type(2)));
typedef float f32x16 __attribute__((ext_vector_type(16)));
typedef unsigned u32x4 __attribute__((ext_vector_type(4)));
typedef unsigned u32x2 __attribute__((ext_vector_type(2)));
typedef GAS unsigned gu32;
#define RLX_AGENT __ATOMIC_RELAXED, __HIP_MEMORY_SCOPE_AGENT
#define LDS_WAIT() asm volatile("s_waitcnt lgkmcnt(0)" ::: "memory")
#define VM_WAIT() asm volatile("s_waitcnt vmcnt(0)" ::: "memory")
#define SBAR() __builtin_amdgcn_sched_barrier(0)

constexpr int NB = 4, SEQ = 2048, DM = 4096, NTOK = NB * SEQ, HD = 128, NFH = 16, NSH = 16;
constexpr int NP = 14336;
constexpr int PC_QF = 0, PC_KF = 2048, PC_VF = 4096, PC_GF = 6144, PC_QS = 8192, PC_KS = 10240, PC_VS = 12288;
constexpr int N_IN_SRC = 14352;
constexpr int NMEM = 256, XH = 4, XW = 512;
constexpr int NE = 32, TOPK = 4, DE = 1024;
constexpr float LN_EPS = 1e-5f, RMS_EPS = 1e-6f;
constexpr float DN_ALPHA = 1.189207115002721f;
constexpr float LOG2E = 1.4426950408889634f;
constexpr float C2 = 0.08838834764831845f * 1.4426950408889634f;
constexpr int QSPLIT = 4, QKS = DM / QSPLIT;

constexpr size_t MiB = 1u << 20;
constexpr size_t WS_CTL = 0, CTL_ZERO_BYTES = 1 * MiB;
constexpr size_t WS_WIN = 16 * MiB;
constexpr size_t WS_WOUT = 128 * MiB;
constexpr size_t WS_WQ = 160 * MiB, WS_WKV = 164 * MiB, WS_WO = 172 * MiB, WS_WF = 176 * MiB, WS_WR = 177 * MiB;
constexpr size_t WS_WUP = 192 * MiB;
constexpr size_t WS_WDN = 704 * MiB;
constexpr size_t WS_H0 = 960 * MiB, WS_MEMN = 1024 * MiB;
constexpr size_t WS_P = 1040 * MiB;
constexpr size_t WS_FL = 1264 * MiB;
constexpr size_t WS_O = 1272 * MiB;
constexpr size_t WS_R = 1336 * MiB;
constexpr size_t WS_H1 = 1464 * MiB;
constexpr size_t WS_KVS = 1528 * MiB;
constexpr size_t WS_QS = 1544 * MiB;
constexpr size_t WS_OX = 1608 * MiB;
constexpr size_t WS_H2 = 1616 * MiB;
constexpr size_t WS_LIST = 1680 * MiB;
constexpr size_t WS_GATE = 1682 * MiB;
constexpr size_t WS_ACT = 1688 * MiB;
constexpr size_t WS_Y = 1768 * MiB;
constexpr size_t WS_END = 2024 * MiB;
constexpr int CW_TMO = 0;
constexpr int CW_BAR = 4096;
constexpr int CW_CNT = 65536;

constexpr int RING_BYTES = 131072;
constexpr int LDSX_OFF = RING_BYTES;
constexpr int MISC_OFF = RING_BYTES + 12288;
constexpr int LDS_BYTES = 147456;

__device__ __forceinline__ unsigned f2bf(float f) { unsigned u = __builtin_bit_cast(unsigned, f); return (u + 0x7fffu + ((u >> 16) & 1u)) >> 16; }
__device__ __forceinline__ unsigned pk2(float lo, float hi) { return f2bf(lo) | (f2bf(hi) << 16); }
__device__ __forceinline__ float bf2f(unsigned short b) { return __builtin_bit_cast(float, (unsigned)b << 16); }
__device__ __forceinline__ float bflo(unsigned w) { return __builtin_bit_cast(float, w << 16); }
__device__ __forceinline__ float bfhi(unsigned w) { return __builtin_bit_cast(float, w & 0xffff0000u); }
__device__ __forceinline__ unsigned cvt_pk_bf16(float lo, float hi) { unsigned r; asm volatile("v_cvt_pk_bf16_f32 %0, %1, %2" : "=v"(r) : "v"(lo), "v"(hi)); return r; }
__device__ __forceinline__ float wave_sum(float v) {
#pragma unroll
    for (int o = 1; o < 64; o <<= 1) v += __shfl_xor(v, o);
    return v;
}

#define XB_TMO      128
#define XB_XCNT(j)  (256  + 64 * (j))
#define XB_XSUB(j)  (1280 + 64 * (j))
#define XB_XGEN(j)  (2304 + 64 * (j))
#define XB_TOP      3328
#define XB_TOPGEN   3392
#define XCD_BAR_WORDS 3456
#define XB_SPIN_CAP (1u << 18)
__device__ __forceinline__ unsigned xb_ld(unsigned* p)              { return __hip_atomic_load(p, __ATOMIC_RELAXED, __HIP_MEMORY_SCOPE_AGENT); }
__device__ __forceinline__ unsigned xb_add(unsigned* p, unsigned v) { return __hip_atomic_fetch_add(p, v, __ATOMIC_RELAXED, __HIP_MEMORY_SCOPE_AGENT); }
__device__ __forceinline__ unsigned xb_xcc_id() { return (unsigned)__builtin_amdgcn_s_getreg((3 << 11) | 20) & 0xFu; }
#define XB_SPIN(cond, bar) do { unsigned _sp = 0; while (cond) { __builtin_amdgcn_s_sleep(1); \
    if ((++_sp & 255u) == 0u) { if (xb_ld(&(bar)[XB_TMO])) break; if (_sp > XB_SPIN_CAP) { atomicAdd(&(bar)[XB_TMO], 1u); break; } } } } while (0)
struct XcdBarrier { unsigned* bar; unsigned x; volatile LAS unsigned* st; };
__device__ __forceinline__ XcdBarrier xcd_barrier_post(unsigned* bar, volatile LAS unsigned* st) {
    XcdBarrier b; b.bar = bar; b.x = xb_xcc_id(); b.st = st;
    if (threadIdx.x == 0) (void)xb_add(&bar[XB_XCNT(b.x)], 1u);
    return b;
}
__device__ __forceinline__ void xcd_barrier_complete(unsigned* bar, unsigned x, unsigned& nloc, unsigned& nx) {
    const unsigned G = gridDim.x * gridDim.y * gridDim.z;
    unsigned sum, cnt, mine, sp = 0u;
    for (;;) {
        sum = 0u; cnt = 0u; mine = 0u;
#pragma unroll
        for (unsigned j = 0; j < 16; ++j) { const unsigned c = xb_ld(&bar[XB_XCNT(j)]); sum += c; cnt += (c > 0u) ? 1u : 0u; mine = (j == x) ? c : mine; }
        if (sum == G) break;
        __builtin_amdgcn_s_sleep(1);
        if ((++sp & 255u) == 0u) { if (xb_ld(&bar[XB_TMO])) break; if (sp > XB_SPIN_CAP) { atomicAdd(&bar[XB_TMO], 1u); break; } }
    }
    nloc = mine > 0u ? mine : 1u; nx = cnt > 0u ? cnt : 1u;
}
__device__ __forceinline__ void xcd_barrier(const XcdBarrier& b) {
    asm volatile("s_waitcnt vmcnt(0)" ::: "memory");
    __syncthreads();
    if (threadIdx.x == 0) {
        unsigned* bar = b.bar;
        __builtin_amdgcn_s_waitcnt(0);
        unsigned nloc = b.st[0], nx = b.st[1];
        if (nloc == 0u) { xcd_barrier_complete(bar, b.x, nloc, nx); b.st[0] = nloc; b.st[1] = nx; }
        const unsigned old = xb_add(&bar[XB_XSUB(b.x)], 1u);
        const unsigned gen = old / nloc;
        if (old + 1u == (gen + 1u) * nloc) {
            __builtin_amdgcn_fence(__ATOMIC_RELEASE, "agent");
            asm volatile("s_waitcnt vmcnt(0)" ::: "memory");
            const unsigned og = xb_add(&bar[XB_TOP], 1u);
            const unsigned tg = og / nx;
            if (og + 1u == (tg + 1u) * nx) xb_add(&bar[XB_TOPGEN], 1u);
            else XB_SPIN(xb_ld(&bar[XB_TOPGEN]) == tg, bar);
            __builtin_amdgcn_fence(__ATOMIC_ACQUIRE, "agent");
            xb_add(&bar[XB_XGEN(b.x)], 1u);
            asm volatile("s_waitcnt vmcnt(0)" ::: "memory");
        } else {
            XB_SPIN(xb_ld(&bar[XB_XGEN(b.x)]) == gen, bar);
            __builtin_amdgcn_fence(__ATOMIC_ACQUIRE, "agent");
            asm volatile("s_waitcnt vmcnt(0)" ::: "memory");
        }
    }
    __syncthreads();
}

namespace pg8 {
constexpr int BM = 256, BK = 64, HALF = 128, HTB = HALF * BK * 2, NXCD = 8, WGM = 8;
__host__ __device__ __forceinline__ int lds_byte(int r, int c) { const int st = (r >> 4) * 2 + (c >> 5), rr = r & 15, cc = c & 31, ob = rr * 64 + cc * 2; return st * 1024 + (ob ^ (((ob >> 9) & 1) << 5)); }
__host__ __device__ __forceinline__ void stage_rc(int b, int& R, int& C) { const int st = b / 1024, sb = b % 1024, swz = sb ^ (((sb >> 9) & 1) << 5); R = (st >> 1) * 16 + swz / 64; C = (st & 1) * 32 + (swz % 64) / 2; }
__host__ __device__ __forceinline__ int perm32(int rho) { const int n = rho >> 4, i = rho & 15; return 8 * (i >> 2) + 4 * n + (i & 3); }
__device__ __forceinline__ int xcd_remap(int L, int nwg) { const int q = nwg / NXCD, r = nwg % NXCD, xcd = L % NXCD, off = L / NXCD; return (xcd < r ? xcd * (q + 1) : r * (q + 1) + (xcd - r) * q) + off; }

struct Unit { int pm, pn, e, aux; };

struct DenseSched {
    const char* A; const char* Bt; int lda, ldb, nM, nN, nwg, G, c;
    __device__ void init(const void* A_, const void* Bt_, int lda_, int ldb_, int M, int N, int G_, int c_) { A = (const char*)A_; Bt = (const char*)Bt_; lda = lda_; ldb = ldb_; nM = M / BM; nN = N / BM; nwg = nM * nN; G = G_; c = c_; }
    __device__ __forceinline__ bool next(int i, Unit& u) const {
        const long L = (long)i * G + c; if (L >= nwg) return false;
        const int wgid = xcd_remap((int)L, nwg);
        const int nig = WGM * nN, gid = wgid / nig, fm = gid * WGM, gsz = (nM - fm) < WGM ? (nM - fm) : WGM;
        u.pm = fm + ((wgid % nig) % gsz); u.pn = (wgid % nig) / gsz; u.e = 0; u.aux = i; return true;
    }
    __device__ __forceinline__ const char* a_base(const Unit& u) const { return A + (size_t)u.pm * BM * lda * 2; }
    __device__ __forceinline__ const char* b_base(const Unit& u) const { return Bt + (size_t)u.pn * BM * ldb * 2; }
    __device__ __forceinline__ int arow(const Unit&, int pos) const { return pos; }
};
struct SplitKSched {
    const char* A; const char* Bt; int lda, ldb, nM, nN, nS, ks, c;
    __device__ __forceinline__ bool next(int i, Unit& u) const {
        if (i > 0 || c < 0 || c >= nM * nN * nS) return false;
        u.e = c % nS; const int t = c / nS; u.pn = t % nN; u.pm = t / nN; u.aux = 0; return true;
    }
    __device__ __forceinline__ const char* a_base(const Unit& u) const { return A + ((size_t)u.pm * BM * lda + (size_t)u.e * ks) * 2; }
    __device__ __forceinline__ const char* b_base(const Unit& u) const { return Bt + ((size_t)u.pn * BM * ldb + (size_t)u.e * ks) * 2; }
    __device__ __forceinline__ int arow(const Unit&, int pos) const { return pos; }
};

template <class Epi, class Sched, bool ALIGN_EPI, bool GATHER>
__device__ __forceinline__ void gemm_phase(LAS unsigned char* lds, const int K, const int lda, const int ldb, const Sched& S, const Epi& E) {
    int tid_ = threadIdx.x; asm volatile("" : "+v"(tid_));
    const int tid = tid_, wid = __builtin_amdgcn_readfirstlane(tid >> 6), lane = tid & 63, wr = wid >> 2, wc = wid & 3, fr = lane & 15, fq = lane >> 4;
    const int nt = K / BK;
    int R0, C0; stage_rc(tid * 16, R0, C0);
    unsigned voffB[2];
    { const int R1 = R0 + 64; const int Rb0 = Epi::PERM ? ((R0 & ~31) + perm32(R0 & 31)) : R0, Rb1 = Epi::PERM ? ((R1 & ~31) + perm32(R1 & 31)) : R1;
      voffB[0] = (unsigned)(Rb0 * ldb + C0) * 2u; voffB[1] = (unsigned)(Rb1 * ldb + C0) * 2u; }
    const size_t kstep = (size_t)(BK * 2);
    const size_t hstepB = (size_t)HALF * ldb * 2;
    const unsigned ldsw = (unsigned)wid * 1024u;
    const int aoff = lds_byte(wr * 64 + fr, fq * 8), boff = lds_byte(wc * 32 + fr, fq * 8);
#define PG8_SA(b, h) (((b) * 2 + (h)) * HTB)
#define PG8_SB(b, h) ((4 + (b) * 2 + (h)) * HTB)
#define PG8_ST2(bufoff, gptr, o0, o1) do { \
        __builtin_amdgcn_global_load_lds((const unsigned*)((const char*)(gptr) + (o0)), (LAS unsigned*)(lds + (bufoff) + ldsw), 16, 0, 0); \
        __builtin_amdgcn_global_load_lds((const unsigned*)((const char*)(gptr) + (o1)), (LAS unsigned*)(lds + (bufoff) + ldsw + 8192), 16, 0, 0); } while (0)
#define PG8_STB(b, h, gptr) PG8_ST2(PG8_SB(b, h), (gptr) + (h) * hstepB, voffB[0], voffB[1])
#define PG8_STA(b, h, gptr, V) PG8_ST2(PG8_SA(b, h), (gptr), V[2 * (h)], V[2 * (h) + 1])
#define PG8_LDA(dst, b, h) do { _Pragma("unroll") for (int m = 0; m < 4; ++m) _Pragma("unroll") for (int k = 0; k < 2; ++k) dst[m][k] = *(const LAS bf16x8*)(lds + PG8_SA(b, h) + aoff + m * 2048 + k * 1024); } while (0)
#define PG8_LDB(dst, b, h) do { _Pragma("unroll") for (int n = 0; n < 2; ++n) _Pragma("unroll") for (int k = 0; k < 2; ++k) dst[n][k] = *(const LAS bf16x8*)(lds + PG8_SB(b, h) + boff + n * 2048 + k * 1024); } while (0)
#define PG8_MMA(ai, bj, At, Bt) do { __builtin_amdgcn_s_setprio(1); _Pragma("unroll") for (int m = 0; m < 4; ++m) _Pragma("unroll") for (int n = 0; n < 2; ++n) _Pragma("unroll") for (int k = 0; k < 2; ++k) \
        acc[ai][bj][m][n] = __builtin_amdgcn_mfma_f32_16x16x32_bf16(Bt[n][k], At[m][k], acc[ai][bj][m][n], 0, 0, 0); __builtin_amdgcn_s_setprio(0); } while (0)
#define PG8_WAIT_V(n) asm volatile("s_waitcnt vmcnt(" #n ")" ::: "memory")
#define PG8_WAIT_L(n) asm volatile("s_waitcnt lgkmcnt(" #n ")" ::: "memory")
#define PG8_BAR __builtin_amdgcn_s_barrier()
#define PG8_SCHED __builtin_amdgcn_sched_barrier(0)
    Unit cur, nxt; int ui = 0;
    if (!S.next(0, cur)) return;
    unsigned vA[4], vAn[4];
#pragma unroll
    for (int j = 0; j < 4; ++j) { const int pos = (j >> 1) * HALF + R0 + (j & 1) * 64; vA[j] = (unsigned)(S.arow(cur, pos) * lda + C0) * 2u; vAn[j] = vA[j]; }
    f32x4 acc[2][2][4][2];
#pragma unroll
    for (int a = 0; a < 2; ++a)
#pragma unroll
        for (int b = 0; b < 2; ++b)
#pragma unroll
            for (int m = 0; m < 4; ++m)
#pragma unroll
                for (int n = 0; n < 2; ++n) acc[a][b][m][n] = (f32x4){0.f, 0.f, 0.f, 0.f};
    bf16x8 At[4][2], B0[2][2], B1[2][2];
    const char* cA = S.a_base(cur); const char* cB = S.b_base(cur);
    PG8_STB(0, 0, cB); PG8_STB(0, 1, cB); PG8_STA(0, 0, cA, vA); PG8_STA(0, 1, cA, vA);
    if (wr == 1) PG8_BAR;
    PG8_WAIT_V(2); PG8_BAR;
    PG8_STB(1, 0, cB + kstep); PG8_STA(1, 0, cA + kstep, vA); PG8_STB(1, 1, cB + kstep);
    PG8_WAIT_V(6); PG8_BAR;
    for (;;) {
        const bool has_next = S.next(ui + 1, nxt);
        const char* nA = has_next ? S.a_base(nxt) : cA; const char* nB = has_next ? S.b_base(nxt) : cB;
        if (GATHER) {
#pragma unroll
            for (int j = 0; j < 4; ++j) { const int pos = (j >> 1) * HALF + R0 + (j & 1) * 64; vAn[j] = has_next ? (unsigned)(S.arow(nxt, pos) * lda + C0) * 2u : vA[j]; }
        }
        for (int t = 0; t < nt; t += 2) {
            const bool last = (t == nt - 2);
            const char* a1 = cA + (size_t)(t + 1) * kstep;
            const char* a2 = last ? nA : cA + (size_t)(t + 2) * kstep; const char* b2 = last ? nB : cB + (size_t)(t + 2) * kstep;
            const char* a3 = a2 + kstep; const char* b3 = b2 + kstep;
            unsigned vX[4];
#pragma unroll
            for (int j = 0; j < 4; ++j) vX[j] = (GATHER && last) ? vAn[j] : vA[j];
            PG8_LDB(B0, 0, 0); PG8_LDB(B1, 0, 1); PG8_SCHED; PG8_LDA(At, 0, 0); PG8_STA(1, 1, a1, vA);
            PG8_WAIT_V(8); PG8_WAIT_L(0); PG8_BAR; PG8_MMA(0, 0, At, B0); PG8_MMA(0, 1, At, B1); PG8_BAR; PG8_SCHED;
            PG8_LDA(At, 0, 1); PG8_STB(0, 0, b2); PG8_STB(0, 1, b2); PG8_STA(0, 0, a2, vX);
            PG8_WAIT_V(8); PG8_WAIT_L(0); PG8_BAR; PG8_MMA(1, 0, At, B0); PG8_MMA(1, 1, At, B1); PG8_BAR; PG8_SCHED;
            PG8_LDB(B0, 1, 0); PG8_LDB(B1, 1, 1); PG8_SCHED; PG8_LDA(At, 1, 0); PG8_STA(0, 1, a2, vX);
            PG8_WAIT_V(8); PG8_WAIT_L(0); PG8_BAR; PG8_MMA(0, 0, At, B0); PG8_MMA(0, 1, At, B1); PG8_BAR; PG8_SCHED;
            PG8_LDA(At, 1, 1); PG8_STB(1, 0, b3); PG8_STB(1, 1, b3); PG8_STA(1, 0, a3, vX);
            PG8_WAIT_V(8); PG8_WAIT_L(0); PG8_BAR; PG8_MMA(1, 0, At, B0); PG8_MMA(1, 1, At, B1); PG8_BAR; PG8_SCHED;
        }
        if constexpr (ALIGN_EPI) { if (wr == 0) PG8_BAR; }
        E(acc, cur, wr, wc, fr, fq);
        if (!has_next) break;
#pragma unroll
        for (int a = 0; a < 2; ++a)
#pragma unroll
            for (int b = 0; b < 2; ++b)
#pragma unroll
                for (int m = 0; m < 4; ++m)
#pragma unroll
                    for (int n = 0; n < 2; ++n) acc[a][b][m][n] = (f32x4){0.f, 0.f, 0.f, 0.f};
        cur = nxt; cA = nA; cB = nB; ++ui;
        if (GATHER) {
#pragma unroll
            for (int j = 0; j < 4; ++j) vA[j] = vAn[j];
        }
        if constexpr (ALIGN_EPI) { if (wr == 1) PG8_BAR; }
    }
    PG8_WAIT_V(0);
    if constexpr (!ALIGN_EPI) { if (wr == 0) PG8_BAR; }
    PG8_BAR;
#undef PG8_SA
#undef PG8_SB
#undef PG8_ST2
#undef PG8_STB
#undef PG8_STA
#undef PG8_LDA
#undef PG8_LDB
#undef PG8_MMA
#undef PG8_WAIT_V
#undef PG8_WAIT_L
#undef PG8_BAR
#undef PG8_SCHED
}

struct EpiBf16 {
    static constexpr bool PERM = true;
    bf16* O; int ldc;
    __device__ __forceinline__ void operator()(const f32x4 (&acc)[2][2][4][2], const Unit& u, int wr, int wc, int fr, int fq) const {
        const int row0 = u.pm * BM + wr * 64 + fr, col0 = u.pn * BM + wc * 32 + 8 * fq;
#pragma unroll
        for (int ai = 0; ai < 2; ++ai)
#pragma unroll
            for (int m = 0; m < 4; ++m) { bf16* rowp = O + (size_t)(row0 + ai * HALF + m * 16) * ldc + col0;
#pragma unroll
                for (int bj = 0; bj < 2; ++bj) { const f32x4 v0 = acc[ai][bj][m][0], v1 = acc[ai][bj][m][1];
                    u32x4 w; w.x = cvt_pk_bf16(v0[0], v0[1]); w.y = cvt_pk_bf16(v0[2], v0[3]); w.z = cvt_pk_bf16(v1[0], v1[1]); w.w = cvt_pk_bf16(v1[2], v1[3]);
                    *(u32x4*)(rowp + bj * HALF) = w; } }
    }
};
struct EpiRes {
    static constexpr bool PERM = false;
    float* C; const bf16* res; int ldc; float alpha;
    __device__ __forceinline__ void operator()(const f32x4 (&acc)[2][2][4][2], const Unit& u, int wr, int wc, int fr, int fq) const {
        const int row0 = u.pm * BM + wr * 64 + fr, col0 = u.pn * BM + wc * 32 + 4 * fq;
#pragma unroll
        for (int ai = 0; ai < 2; ++ai)
#pragma unroll
            for (int m = 0; m < 4; ++m) { const size_t off = (size_t)(row0 + ai * HALF + m * 16) * ldc + col0;
#pragma unroll
                for (int bj = 0; bj < 2; ++bj)
#pragma unroll
                    for (int n = 0; n < 2; ++n) { const u32x2 rr = *(const u32x2*)(res + off + bj * HALF + n * 16);
                        f32x4 o = acc[ai][bj][m][n]; o[0] += alpha * bflo(rr.x); o[1] += alpha * bfhi(rr.x); o[2] += alpha * bflo(rr.y); o[3] += alpha * bfhi(rr.y);
                        *(f32x4*)(C + off + bj * HALF + n * 16) = o; } }
    }
};
struct EpiSlab {
    static constexpr bool PERM = false;
    float* C; int ldc; size_t slab;
    __device__ __forceinline__ void operator()(const f32x4 (&acc)[2][2][4][2], const Unit& u, int wr, int wc, int fr, int fq) const {
        const int row0 = u.pm * BM + wr * 64 + fr, col0 = u.pn * BM + wc * 32 + 4 * fq; float* base = C + (size_t)u.e * slab;
#pragma unroll
        for (int ai = 0; ai < 2; ++ai)
#pragma unroll
            for (int m = 0; m < 4; ++m) { float* rowp = base + (size_t)(row0 + ai * HALF + m * 16) * ldc + col0;
#pragma unroll
                for (int bj = 0; bj < 2; ++bj)
#pragma unroll
                    for (int n = 0; n < 2; ++n) *(f32x4*)(rowp + bj * HALF + n * 16) = acc[ai][bj][m][n]; }
    }
};
}

struct Params {
    const float *x, *mem, *ln_in_g, *ln_in_b, *w_in, *b_f, *fq_g, *fk_g, *mix_g, *w_out, *ln_mix_g, *ln_mix_b, *mem_ln_g, *mem_ln_b,
                *xa_wq, *xa_wkv, *xa_wo, *ln_xa_g, *ln_xa_b, *router_w, *router_b, *w_up, *b_up, *w_down, *b_down, *ln_moe_g, *ln_moe_b;
    float* out; unsigned char* ws; int ph_lo, ph_hi;
};
#define CAS __attribute__((address_space(4)))
typedef const CAS Params* PP;
#define P_FRESH(pq) asm volatile("" : "+s"(pq))
struct Frame {
    LAS unsigned char* lds; volatile LAS unsigned* MISC; gu32* ctl;
    int tid, lane, wave, vcu, G;
    __device__ __forceinline__ void fresh() { int t = threadIdx.x; asm volatile("" : "+v"(t)); tid = t; lane = t & 63; wave = __builtin_amdgcn_readfirstlane(t >> 6); }
};

__device__ __forceinline__ void tr_item(const float* W, int ldw, int k0, int scol, bf16* WT, int ldk, int drow, LAS float* scr, int lane) {
#pragma unroll 8
    for (int i = 0; i < 32; ++i) { const int kk = 2 * i + (lane >> 5); scr[kk * 33 + (lane & 31)] = W[(size_t)(k0 + kk) * ldw + scol + (lane & 31)]; }
    LDS_WAIT(); asm volatile("" ::: "memory");
    const int c = lane & 7;
#pragma unroll
    for (int j = 0; j < 4; ++j) { const int n = (lane >> 3) + 8 * j; const LAS float* s = scr + (8 * c) * 33 + n;
        u32x4 o; o.x = pk2(s[0 * 33], s[1 * 33]); o.y = pk2(s[2 * 33], s[3 * 33]); o.z = pk2(s[4 * 33], s[5 * 33]); o.w = pk2(s[6 * 33], s[7 * 33]);
        *(GAS u32x4*)(WT + (size_t)(drow + n) * ldk + k0 + 8 * c) = o; }
    LDS_WAIT(); asm volatile("" ::: "memory");
}
__device__ __forceinline__ void ln_row_store(f32x4 (&v)[16], const float* g, const float* b, bf16* orow, float* orow32, int lane) {
    float s = 0.f;
#pragma unroll
    for (int j = 0; j < 16; ++j) s += (v[j].x + v[j].y) + (v[j].z + v[j].w);
    const float mean = wave_sum(s) * (1.f / DM); float s2 = 0.f;
#pragma unroll
    for (int j = 0; j < 16; ++j) { v[j] = v[j] - mean; s2 += (v[j].x * v[j].x + v[j].y * v[j].y) + (v[j].z * v[j].z + v[j].w * v[j].w); }
    const float rstd = 1.f / sqrtf(wave_sum(s2) * (1.f / DM) + LN_EPS);
    const GAS f32x4* g4 = (const GAS f32x4*)g + lane; const GAS f32x4* b4 = (const GAS f32x4*)b + lane;
#pragma unroll
    for (int j = 0; j < 16; ++j) { const f32x4 gg = g4[64 * j], bb = b4[64 * j]; const f32x4 y = v[j] * rstd * gg + bb;
        if (orow) ((GAS u32x2*)orow)[lane + 64 * j] = (u32x2){pk2(y.x, y.y), pk2(y.z, y.w)};
        if (orow32) ((GAS f32x4*)orow32)[lane + 64 * j] = y; }
}
__device__ __forceinline__ void ln_row_f32(const float* xrow, const float* g, const float* b, bf16* orow, int lane) {
    f32x4 v[16];
#pragma unroll
    for (int j = 0; j < 16; ++j) v[j] = ((const GAS f32x4*)xrow)[lane + 64 * j];
    ln_row_store(v, g, b, orow, nullptr, lane);
}

constexpr int SHM_KV = 64 * HD * 2;
#define KSWZ(row, colB) ((row) * 256 + ((colB) ^ (((row) & 7) << 4)))
__device__ __forceinline__ int v_st(int k, int c) { const int kk = (k & ~0xC) | ((k & 4) << 1) | ((k & 8) >> 1); return ((kk >> 3) * 4 + (c >> 5)) * 512 + ((kk & 7) * 32 + (c & 31)) * 2; }
__device__ __forceinline__ int v_rd_base(int lane) { return ((lane & 3) << 3) | (((lane >> 2) & 3) << 6) | (((lane >> 4) & 1) << 5) | (((lane >> 5) & 1) << 8); }
constexpr int v_rd_off(int d0, int ks, int half) { return d0 * 512 + ks * 4096 + half * 2048; }
__device__ __forceinline__ int crow(int r, int hi) { return (r & 3) + 8 * (r >> 2) + 4 * hi; }
__device__ __forceinline__ bf16x8 pack8(f32x4 a, f32x4 b) { u32x4 w = {cvt_pk_bf16(a[0], a[1]), cvt_pk_bf16(a[2], a[3]), cvt_pk_bf16(b[0], b[1]), cvt_pk_bf16(b[2], b[3])}; return __builtin_bit_cast(bf16x8, w); }
__device__ __forceinline__ void qkt(f32x16& p0, f32x16& p1, LAS const unsigned char* Kt, int r32, int hi, const bf16x8* qr) {
    p0 = f32x16{}; p1 = f32x16{};
    LAS const unsigned char* kb[4];
#pragma unroll
    for (int dd = 0; dd < 4; ++dd) kb[dd] = Kt + KSWZ(r32, (dd * 16 + hi * 8) * 2);
#pragma unroll
    for (int d0 = 0; d0 < 8; ++d0) { LAS const unsigned char* a = kb[d0 & 3] + (d0 >> 2) * 128;
        const bf16x8 b0 = *(LAS const bf16x8*)a; const bf16x8 b1 = *(LAS const bf16x8*)(a + 32 * 256);
        p0 = __builtin_amdgcn_mfma_f32_32x32x16_bf16(b0, qr[d0], p0, 0, 0, 0);
        p1 = __builtin_amdgcn_mfma_f32_32x32x16_bf16(b1, qr[d0], p1, 0, 0, 0); }
}
__device__ __forceinline__ void pack_p(const f32x16& p0, const f32x16& p1, bf16x8& pa0, bf16x8& pa1, bf16x8& pa2, bf16x8& pa3) {
#define PK4(P, B_, OUT) do { unsigned a0 = cvt_pk_bf16(P[B_+0], P[B_+1]), a1 = cvt_pk_bf16(P[B_+2], P[B_+3]); \
        unsigned b0 = cvt_pk_bf16(P[B_+4], P[B_+5]), b1 = cvt_pk_bf16(P[B_+6], P[B_+7]); \
        auto r0 = __builtin_amdgcn_permlane32_swap(a0, b0, false, false); auto r1 = __builtin_amdgcn_permlane32_swap(a1, b1, false, false); \
        u32x4 w = {r0[0], r1[0], r0[1], r1[1]}; OUT = __builtin_bit_cast(bf16x8, w); } while (0)
    PK4(p0, 0, pa0); PK4(p0, 8, pa1); PK4(p1, 0, pa2); PK4(p1, 8, pa3);
#undef PK4
}
__device__ __forceinline__ void pv_tile(f32x16* o, int vb0, bf16x8 pa0, bf16x8 pa1, bf16x8 pa2, bf16x8 pa3) {
#define TRRD(dst, off) asm volatile("ds_read_b64_tr_b16 %0, %1 offset:%2" : "=&v"(dst) : "v"(vb0), "i"(off) : "memory")
#define PV_D0(d0) do { s16x4 l0, l1, l2, l3, h0, h1, h2, h3; constexpr int b_ = v_rd_off(d0, 0, 0); \
        TRRD(l0, b_); TRRD(h0, b_ + 2048); TRRD(l1, b_ + 4096); TRRD(h1, b_ + 6144); TRRD(l2, b_ + 8192); TRRD(h2, b_ + 10240); TRRD(l3, b_ + 12288); TRRD(h3, b_ + 14336); \
        asm volatile("s_waitcnt lgkmcnt(0)" ::: "memory"); SBAR(); \
        o[d0] = __builtin_amdgcn_mfma_f32_32x32x16_bf16(pa0, (bf16x8){l0[0], l0[1], l0[2], l0[3], h0[0], h0[1], h0[2], h0[3]}, o[d0], 0, 0, 0); \
        o[d0] = __builtin_amdgcn_mfma_f32_32x32x16_bf16(pa1, (bf16x8){l1[0], l1[1], l1[2], l1[3], h1[0], h1[1], h1[2], h1[3]}, o[d0], 0, 0, 0); \
        o[d0] = __builtin_amdgcn_mfma_f32_32x32x16_bf16(pa2, (bf16x8){l2[0], l2[1], l2[2], l2[3], h2[0], h2[1], h2[2], h2[3]}, o[d0], 0, 0, 0); \
        o[d0] = __builtin_amdgcn_mfma_f32_32x32x16_bf16(pa3, (bf16x8){l3[0], l3[1], l3[2], l3[3], h3[0], h3[1], h3[2], h3[3]}, o[d0], 0, 0, 0); } while (0)
    PV_D0(0); PV_D0(1); PV_D0(2); PV_D0(3);
#undef PV_D0
#undef TRRD
}

constexpr int AT_K = 0, AT_V = 2 * SHM_KV, AT_C2 = 4 * SHM_KV, AT_RK = AT_C2 + 8192, AT_WS = AT_RK + 8192, AT_OST = AT_WS + 2048, OST_WAVE = 32 * 33 * 4, AT_END = AT_OST + 8 * OST_WAVE;
static_assert(AT_END <= RING_BYTES, "attention LDS map");

__device__ __forceinline__ void o_rows(const f32x16* o, const float (&il)[16], LAS float* ost, int lane, float (&v)[4][16], float& ss) {
    const int r32 = lane & 31, hi = lane >> 5, row = lane >> 1, half = lane & 1; ss = 0.f;
#pragma unroll
    for (int d0 = 0; d0 < 4; ++d0) {
#pragma unroll
        for (int r = 0; r < 16; ++r) ost[crow(r, hi) * 33 + r32] = o[d0][r] * il[r];
        LDS_WAIT(); asm volatile("" ::: "memory");
#pragma unroll
        for (int i = 0; i < 16; ++i) { v[d0][i] = ost[row * 33 + 16 * half + i]; }
        LDS_WAIT(); asm volatile("" ::: "memory");
#pragma unroll
        for (int i = 0; i < 16; ++i) ss += v[d0][i] * v[d0][i];
    }
}
__device__ __forceinline__ void store16_bf16(bf16* dst, const float (&y)[16]) {
    u32x4 w0 = {cvt_pk_bf16(y[0], y[1]), cvt_pk_bf16(y[2], y[3]), cvt_pk_bf16(y[4], y[5]), cvt_pk_bf16(y[6], y[7])};
    u32x4 w1 = {cvt_pk_bf16(y[8], y[9]), cvt_pk_bf16(y[10], y[11]), cvt_pk_bf16(y[12], y[13]), cvt_pk_bf16(y[14], y[15])};
    *(GAS u32x4*)dst = w0; *(GAS u32x4*)(dst + 8) = w1;
}
__device__ __forceinline__ void fox_tables(Frame F, PP p, int b, int h) {
    F.fresh();
    LAS float* c2t = (LAS float*)(F.lds + AT_C2); LAS float* rkt = (LAS float*)(F.lds + AT_RK); LAS float* red = (LAS float*)(F.lds + AT_WS);
    const float* FL = (const float*)(p->ws + WS_FL); const float bfh = p->b_f[h];
    __syncthreads();
    float v[4], run = 0.f;
#pragma unroll
    for (int i = 0; i < 4; ++i) { const float x = FL[(size_t)(b * SEQ + 4 * F.tid + i) * 16 + h] + bfh; const float y = -x * LOG2E;
        const float sp = fmaxf(y, 0.f) + __builtin_amdgcn_logf(1.f + __builtin_amdgcn_exp2f(-fabsf(y))); run -= sp; v[i] = run; }
    float incl = run;
#pragma unroll
    for (int o = 1; o < 64; o <<= 1) { const float t = __shfl_up(incl, o); if (F.lane >= o) incl += t; }
    if (F.lane == 63) red[F.wave] = incl;
    __syncthreads();
    float woff = 0.f;
    for (int w = 0; w < F.wave; ++w) woff += red[w];
    const float base = woff + incl - run;
#pragma unroll
    for (int i = 0; i < 4; ++i) c2t[4 * F.tid + i] = v[i] + base;
    const bf16* Kg = (const bf16*)(p->ws + WS_P) + (size_t)(b * SEQ) * NP + PC_KF + h * HD + (F.lane & 15) * 8;
#pragma unroll 8
    for (int it = 0; it < 64; ++it) { const int s = F.wave * 256 + it * 4 + (F.lane >> 4);
        const u32x4 w = *(const GAS u32x4*)(Kg + (size_t)s * NP);
        float ss = bflo(w.x) * bflo(w.x) + bfhi(w.x) * bfhi(w.x) + bflo(w.y) * bflo(w.y) + bfhi(w.y) * bfhi(w.y) + bflo(w.z) * bflo(w.z) + bfhi(w.z) * bfhi(w.z) + bflo(w.w) * bflo(w.w) + bfhi(w.w) * bfhi(w.w);
        ss += __shfl_xor(ss, 1); ss += __shfl_xor(ss, 2); ss += __shfl_xor(ss, 4); ss += __shfl_xor(ss, 8);
        if ((F.lane & 15) == 0) rkt[s] = 1.f / sqrtf(ss * (1.f / HD) + RMS_EPS); }
    __syncthreads();
}

template <int MODE>
__device__ __forceinline__ void attn_unit(Frame F, PP p, int b, int h, int qb) {
    F.fresh();
    const int lane = F.lane, wave = F.wave, r32 = lane & 31, hi = lane >> 5;
    const bf16* Pg = (const bf16*)(p->ws + WS_P) + (size_t)(b * SEQ) * NP;
    const int cq = (MODE == 0 ? PC_QF : PC_QS) + h * HD, ck = (MODE == 0 ? PC_KF : PC_KS) + h * HD, cv = (MODE == 0 ? PC_VF : PC_VS) + h * HD;
    LAS const float* c2t = (LAS const float*)(F.lds + AT_C2); LAS const float* rkt = (LAS const float*)(F.lds + AT_RK);
    const int trow = 256 * qb + 32 * wave;
    const int jd = 4 * qb + (wave >> 1), lam = 32 * (wave & 1) + r32, NT = 4 * qb + 4;
    unsigned dk[2], dv[2];
#pragma unroll
    for (int i = 0; i < 2; ++i) { const int q = (wave * 2 + i) * 1024 + lane * 16;
        { const int row = q >> 8, cb = (q & 255) ^ ((row & 7) << 4); dk[i] = (unsigned)(row * NP + ck + (cb >> 1)); }
        { const int st = q >> 9, inner = (q & 511) >> 1, kk = (st >> 2) * 8 + (inner >> 5), c = (st & 3) * 32 + (inner & 31); const int k = (kk & ~0xC) | ((kk & 4) << 1) | ((kk & 8) >> 1);
          dv[i] = (unsigned)(k * NP + cv + c); } }
#define AT_DMA(j, bf) do { const bf16* tb_ = Pg + (size_t)(64 * (j)) * NP; LAS unsigned char* kd_ = F.lds + AT_K + (bf) * SHM_KV + wave * 2048; LAS unsigned char* vd_ = F.lds + AT_V + (bf) * SHM_KV + wave * 2048; \
        __builtin_amdgcn_global_load_lds((const unsigned*)(tb_ + dk[0]), (LAS unsigned*)kd_, 16, 0, 0); __builtin_amdgcn_global_load_lds((const unsigned*)(tb_ + dk[1]), (LAS unsigned*)(kd_ + 1024), 16, 0, 0); \
        __builtin_amdgcn_global_load_lds((const unsigned*)(tb_ + dv[0]), (LAS unsigned*)vd_, 16, 0, 0); __builtin_amdgcn_global_load_lds((const unsigned*)(tb_ + dv[1]), (LAS unsigned*)(vd_ + 1024), 16, 0, 0); } while (0)
    __syncthreads();
    AT_DMA(MODE == 0 ? 0 : NT - 1, 0);
    bf16x8 qr[8];
    { const bf16* qp = Pg + (size_t)(trow + r32) * NP + cq + hi * 8;
      u32x4 raw[8];
#pragma unroll
      for (int d0 = 0; d0 < 8; ++d0) raw[d0] = *(const GAS u32x4*)(qp + 16 * d0);
      float sc_q = C2;
      if (MODE == 0) { float ss = 0.f;
#pragma unroll
          for (int d0 = 0; d0 < 8; ++d0) { const u32x4 w = raw[d0]; ss += bflo(w.x) * bflo(w.x) + bfhi(w.x) * bfhi(w.x) + bflo(w.y) * bflo(w.y) + bfhi(w.y) * bfhi(w.y) + bflo(w.z) * bflo(w.z) + bfhi(w.z) * bfhi(w.z) + bflo(w.w) * bflo(w.w) + bfhi(w.w) * bfhi(w.w); }
          ss += __shfl_xor(ss, 32); sc_q = C2 / sqrtf(ss * (1.f / HD) + RMS_EPS); }
#pragma unroll
      for (int d0 = 0; d0 < 8; ++d0) { const u32x4 w = raw[d0]; f32x4 a = {bflo(w.x), bfhi(w.x), bflo(w.y), bfhi(w.y)}, c = {bflo(w.z), bfhi(w.z), bflo(w.w), bfhi(w.w)};
          if (MODE == 0) { const GAS f32x4* gq = (const GAS f32x4*)(p->fq_g + 16 * d0 + 8 * hi); const GAS f32x4* gk = (const GAS f32x4*)(p->fk_g + 16 * d0 + 8 * hi);
              a = a * (gq[0] * gk[0]); c = c * (gq[1] * gk[1]); asm volatile("" ::: "memory"); }
          qr[d0] = pack8(a * sc_q, c * sc_q); } }
    f32x16 o[4] = {};
    float lsum = 0.f;
    const float ref = (MODE == 0) ? c2t[trow + 31] : 0.f;
    bf16x8 Atri0, Atri1, Aone; f32x16 carry = {};
    if (MODE == 1) {
#pragma unroll
        for (int j = 0; j < 8; ++j) { const int k0 = 8 * (j >> 2) + 4 * hi + (j & 3); Atri0[j] = (k0 > r32) ? (short)0xBF80 : (short)0; Atri1[j] = (16 + k0 > r32) ? (short)0xBF80 : (short)0; Aone[j] = (short)0xBF80; }
    }
    const int koff = KSWZ(r32, hi * 16), vroff = v_rd_base(lane);
    for (int it = 0; it < NT; ++it) {
        const int j = (MODE == 0) ? it : NT - 1 - it; const int bf = it & 1;
        asm volatile("s_waitcnt vmcnt(0)" ::: "memory");
        __syncthreads();
        if (it + 1 < NT) AT_DMA(MODE == 0 ? it + 1 : NT - 2 - it, bf ^ 1);
        if (j <= jd) {
            LAS const unsigned char* Kt = F.lds + AT_K + bf * SHM_KV; const int vb0 = (int)(uintptr_t)(F.lds + AT_V + bf * SHM_KV) + vroff;
            f32x16 p0 = {}, p1 = {};
#pragma unroll
            for (int d0 = 0; d0 < 8; ++d0) { LAS const unsigned char* a = Kt + (koff ^ ((d0 & 3) << 5)) + (d0 >> 2) * 128;
                const bf16x8 b0 = *(LAS const bf16x8*)a; const bf16x8 b1 = *(LAS const bf16x8*)(a + 32 * 256);
                p0 = __builtin_amdgcn_mfma_f32_32x32x16_bf16(b0, qr[d0], p0, 0, 0, 0);
                p1 = __builtin_amdgcn_mfma_f32_32x32x16_bf16(b1, qr[d0], p1, 0, 0, 0); }
            if (MODE == 0) {
#pragma unroll
                for (int g = 0; g < 4; ++g) { const f32x4 rk0 = *(LAS const f32x4*)(rkt + 64 * j + 8 * g + 4 * hi), rk1 = *(LAS const f32x4*)(rkt + 64 * j + 32 + 8 * g + 4 * hi);
                    const f32x4 cc0 = *(LAS const f32x4*)(c2t + 64 * j + 8 * g + 4 * hi), cc1 = *(LAS const f32x4*)(c2t + 64 * j + 32 + 8 * g + 4 * hi);
#pragma unroll
                    for (int i = 0; i < 4; ++i) { p0[4 * g + i] = fmaf(p0[4 * g + i], rk0[i], ref - cc0[i]); p1[4 * g + i] = fmaf(p1[4 * g + i], rk1[i], ref - cc1[i]); }
                    if (g & 1) asm volatile("" ::: "memory"); }
                if (j == jd) { int lam2 = lam - 4 * hi; asm volatile("" : "+v"(lam2));
#pragma unroll
                    for (int r = 0; r < 16; ++r) { const int kap = (r & 3) + 8 * (r >> 2); if (kap > lam2) p0[r] = -__builtin_inff(); if (kap + 32 > lam2) p1[r] = -__builtin_inff(); } }
#pragma unroll
                for (int r = 0; r < 16; ++r) { p0[r] = __builtin_amdgcn_exp2f(p0[r]); p1[r] = __builtin_amdgcn_exp2f(p1[r]); lsum += p0[r] + p1[r]; }
            } else {
                f32x16 s0, s1;
#pragma unroll
                for (int r = 0; r < 16; ++r) { s0[r] = __builtin_amdgcn_logf(1.f + __builtin_amdgcn_exp2f(p0[r])); s1[r] = __builtin_amdgcn_logf(1.f + __builtin_amdgcn_exp2f(p1[r])); }
                if (j == jd) { int lam2 = lam - 4 * hi; asm volatile("" : "+v"(lam2));
#pragma unroll
                    for (int r = 0; r < 16; ++r) { const int kap = (r & 3) + 8 * (r >> 2); if (kap >= lam2) s0[r] = 0.f; if (kap + 32 >= lam2) s1[r] = 0.f; } }
#pragma unroll
                for (int r = 0; r < 16; ++r) { p0[r] -= s0[r]; p1[r] -= s1[r]; }
                const float s00 = s0[0];
                const bf16x8 bs0 = pack8((f32x4){s0[0], s0[1], s0[2], s0[3]}, (f32x4){s0[4], s0[5], s0[6], s0[7]}), bs1 = pack8((f32x4){s0[8], s0[9], s0[10], s0[11]}, (f32x4){s0[12], s0[13], s0[14], s0[15]});
                const bf16x8 bs2 = pack8((f32x4){s1[0], s1[1], s1[2], s1[3]}, (f32x4){s1[4], s1[5], s1[6], s1[7]}), bs3 = pack8((f32x4){s1[8], s1[9], s1[10], s1[11]}, (f32x4){s1[12], s1[13], s1[14], s1[15]});
                f32x16 t0 = __builtin_amdgcn_mfma_f32_32x32x16_bf16(Atri0, bs0, carry, 0, 0, 0);
                f32x16 t1 = __builtin_amdgcn_mfma_f32_32x32x16_bf16(Atri0, bs2, carry, 0, 0, 0);
                t0 = __builtin_amdgcn_mfma_f32_32x32x16_bf16(Atri1, bs1, t0, 0, 0, 0);
                t1 = __builtin_amdgcn_mfma_f32_32x32x16_bf16(Atri1, bs3, t1, 0, 0, 0);
                t0 = __builtin_amdgcn_mfma_f32_32x32x16_bf16(Aone, bs2, t0, 0, 0, 0);
                t0 = __builtin_amdgcn_mfma_f32_32x32x16_bf16(Aone, bs3, t0, 0, 0, 0);
                { const float cv_ = t0[0] - s00; auto rr = __builtin_amdgcn_permlane32_swap(__float_as_uint(cv_), __float_as_uint(cv_), false, false); const float cn = __uint_as_float(rr[0]);
#pragma unroll
                  for (int r = 0; r < 16; ++r) carry[r] = cn; }
#pragma unroll
                for (int r = 0; r < 16; ++r) { p0[r] = __builtin_amdgcn_exp2f(p0[r] + t0[r]); p1[r] = __builtin_amdgcn_exp2f(p1[r] + t1[r]); }
                if (j == jd) { int lam2 = lam - 4 * hi; asm volatile("" : "+v"(lam2));
#pragma unroll
                    for (int r = 0; r < 16; ++r) { const int kap = (r & 3) + 8 * (r >> 2); if (kap >= lam2) p0[r] = 0.f; if (kap + 32 >= lam2) p1[r] = 0.f; } }
            }
            bf16x8 pa0, pa1, pa2, pa3;
            pack_p(p0, p1, pa0, pa1, pa2, pa3);
            pv_tile(o, vb0, pa0, pa1, pa2, pa3);
        }
    }
#undef AT_DMA
    int b2 = b, h2 = h, qb2 = qb;
    asm volatile("" : "+s"(b2), "+s"(h2), "+s"(qb2));
    P_FRESH(p);
    LAS float* wsw = (LAS float*)(F.lds + AT_WS) + 64 + wave * 48; LAS float* ost = (LAS float*)(F.lds + AT_OST + wave * OST_WAVE);
    float il[16];
    if (MODE == 0) { lsum += __shfl_xor(lsum, 32); if (hi == 0) wsw[r32] = 1.f / lsum; LDS_WAIT(); asm volatile("" ::: "memory");
#pragma unroll
        for (int r = 0; r < 16; ++r) il[r] = wsw[crow(r, hi)]; }
    else {
#pragma unroll
        for (int r = 0; r < 16; ++r) il[r] = 1.f; }
    float v[4][16], ss;
    o_rows(o, il, ost, lane, v, ss);
    ss += __shfl_xor(ss, 1);
    const float rstd = 1.f / sqrtf(ss * (1.f / HD) + RMS_EPS);
    const int row = lane >> 1, half = lane & 1; const size_t srow = (size_t)b2 * SEQ + 256 * qb2 + 32 * wave + row;
    const float* mg = p->mix_g + (MODE == 0 ? h2 : NFH + h2) * HD + 16 * half;
    bf16* Og = (bf16*)(p->ws + WS_O) + srow * DM + (MODE == 0 ? 0 : NFH * HD) + h2 * HD + 16 * half;
    const bf16* Gg = (const bf16*)(p->ws + WS_P) + srow * NP + PC_GF + h2 * HD + 16 * half;
#pragma unroll
    for (int d0 = 0; d0 < 4; ++d0) { float y[16];
#pragma unroll
        for (int q4 = 0; q4 < 4; ++q4) { const f32x4 g4 = *(const GAS f32x4*)(mg + 32 * d0 + 4 * q4);
#pragma unroll
            for (int i = 0; i < 4; ++i) y[4 * q4 + i] = v[d0][4 * q4 + i] * rstd * g4[i]; }
        if (MODE == 0) { const u32x4 ga = *(const GAS u32x4*)(Gg + 32 * d0), gb = *(const GAS u32x4*)(Gg + 32 * d0 + 8);
            const unsigned gw[8] = {ga.x, ga.y, ga.z, ga.w, gb.x, gb.y, gb.z, gb.w};
#pragma unroll
            for (int i = 0; i < 8; ++i) { y[2 * i] *= 1.f / (1.f + __builtin_amdgcn_exp2f(-LOG2E * bflo(gw[i]))); y[2 * i + 1] *= 1.f / (1.f + __builtin_amdgcn_exp2f(-LOG2E * bfhi(gw[i]))); } }
        store16_bf16(Og + 32 * d0, y); asm volatile("" ::: "memory"); }
}

__device__ __forceinline__ void xattn_unit(Frame F, PP p, int b, int xh, int qblk) {
    F.fresh();
    const int lane = F.lane, wave = F.wave, tid = F.tid, r32 = lane & 31, hi = lane >> 5;
    const float* QS = (const float*)(p->ws + WS_QS); const float* KVS = (const float*)(p->ws + WS_KVS);
    LAS unsigned char* Kt = F.lds; LAS unsigned char* Vt = F.lds + 65536;
    const int sr = tid >> 4, sc = (tid & 15) * 8, vst0 = v_st(sr, sc), vst1 = v_st(32 + sr, sc), kws = KSWZ(sr, sc * 2);
    __syncthreads();
#pragma unroll 1
    for (int t = 0; t < 4; ++t) {
#pragma unroll
        for (int rr = 0; rr < 2; ++rr) {
            const size_t rowoff = (size_t)(b * NMEM + 64 * t + sr + 32 * rr) * (2 * XW) + xh * HD + sc;
            f32x4 ka = {0.f, 0.f, 0.f, 0.f}, kb = ka, va = ka, vb = ka;
#pragma unroll
            for (int s = 0; s < QSPLIT; ++s) { const float* base = KVS + (size_t)s * (NB * NMEM) * (2 * XW) + rowoff;
                ka += *(const GAS f32x4*)(base); kb += *(const GAS f32x4*)(base + 4); va += *(const GAS f32x4*)(base + XW); vb += *(const GAS f32x4*)(base + XW + 4); }
            *(LAS bf16x8*)(Kt + t * SHM_KV + kws + rr * 32 * 256) = pack8(ka, kb);
            *(LAS bf16x8*)(Vt + t * SHM_KV + (rr ? vst1 : vst0)) = pack8(va, vb);
        }
    }
    __syncthreads();
    f32x16 o[4] = {}; float lsum = 0.f, m = -1e30f;
    const size_t tok0 = (size_t)b * SEQ + 128 * qblk + 32 * (wave & 3);
    if (wave < 4) {
        bf16x8 qr[8];
#pragma unroll
        for (int d0 = 0; d0 < 8; ++d0) { f32x4 a = {0.f, 0.f, 0.f, 0.f}, c = a;
#pragma unroll
            for (int s = 0; s < QSPLIT; ++s) { const float* qp = QS + ((size_t)s * NTOK + tok0 + r32) * XW + xh * HD + 16 * d0 + 8 * hi; a += *(const GAS f32x4*)qp; c += *(const GAS f32x4*)(qp + 4); }
            qr[d0] = pack8(a * C2, c * C2); }
#pragma unroll 1
        for (int t = 0; t < 4; ++t) { f32x16 p0, p1; qkt(p0, p1, Kt + t * SHM_KV, r32, hi, qr);
#pragma unroll
            for (int r = 0; r < 16; ++r) m = fmaxf(m, fmaxf(p0[r], p1[r])); }
        { auto rr = __builtin_amdgcn_permlane32_swap(__float_as_uint(m), __float_as_uint(m), false, false); m = fmaxf(__uint_as_float(rr[0]), __uint_as_float(rr[1])); }
#pragma unroll 1
        for (int t = 0; t < 4; ++t) { f32x16 p0, p1; qkt(p0, p1, Kt + t * SHM_KV, r32, hi, qr);
#pragma unroll
            for (int r = 0; r < 16; ++r) { p0[r] = __builtin_amdgcn_exp2f(p0[r] - m); p1[r] = __builtin_amdgcn_exp2f(p1[r] - m); lsum += p0[r] + p1[r]; }
            bf16x8 pa0, pa1, pa2, pa3; pack_p(p0, p1, pa0, pa1, pa2, pa3);
            pv_tile(o, (int)(uintptr_t)(Vt + t * SHM_KV) + v_rd_base(lane), pa0, pa1, pa2, pa3); }
        lsum += __shfl_xor(lsum, 32);
    }
    __syncthreads();
    if (wave < 4) {
        LAS float* wsw = (LAS float*)(F.lds + 32768) + wave * 64; LAS float* ost = (LAS float*)(F.lds + wave * OST_WAVE);
        if (hi == 0) wsw[r32] = 1.f / lsum; LDS_WAIT(); asm volatile("" ::: "memory");
        float il[16];
#pragma unroll
        for (int r = 0; r < 16; ++r) il[r] = wsw[crow(r, hi)];
        float v[4][16], ss; o_rows(o, il, ost, lane, v, ss);
        const int row = lane >> 1, half = lane & 1;
        bf16* Og = (bf16*)(p->ws + WS_OX) + (tok0 + row) * XW + xh * HD + 16 * half;
#pragma unroll
        for (int d0 = 0; d0 < 4; ++d0) store16_bf16(Og + 32 * d0, v[d0]);
    }
}

__device__ __forceinline__ void flogit_rows(Frame F, PP p, int row0  ) {
    F.fresh();
    typedef float f32x4v __attribute__((ext_vector_type(4)));
    const bf16* H0 = (const bf16*)(p->ws + WS_H0); const bf16* WfT = (const bf16*)(p->ws + WS_WF);
    const int rt = F.wave >> 2, kq = F.wave & 3, l15 = F.lane & 15, lq = F.lane >> 4;
    const bf16* ap = H0 + (size_t)(row0 + 16 * rt + l15) * DM + kq * 1024 + 8 * lq;
    const bf16* bp = WfT + (size_t)l15 * DM + kq * 1024 + 8 * lq;
    f32x4v acc = {0.f, 0.f, 0.f, 0.f};
#pragma unroll 8
    for (int ks = 0; ks < 32; ++ks) { const bf16x8 a = *(const GAS bf16x8*)(ap + 32 * ks), bb = *(const GAS bf16x8*)(bp + 32 * ks);
        acc = __builtin_amdgcn_mfma_f32_16x16x32_bf16(a, bb, acc, 0, 0, 0); }
    LAS float* red = (LAS float*)F.lds;
    __syncthreads();
#pragma unroll
    for (int i = 0; i < 4; ++i) red[F.wave * 256 + (4 * lq + i) * 16 + l15] = acc[i];
    __syncthreads();
    { const int t = F.tid, rt2 = t >> 8, rc = t & 255; const LAS float* q = red + rt2 * 1024 + rc;
      ((float*)(p->ws + WS_FL))[(size_t)(row0 + 16 * rt2 + (rc >> 4)) * 16 + (rc & 15)] = (q[0] + q[256]) + (q[512] + q[768]); }
}

__device__ __forceinline__ void router_rows(Frame F, PP p, int row0  ) {
    F.fresh();
    typedef float f32x4v __attribute__((ext_vector_type(4)));
    const bf16* H2 = (const bf16*)(p->ws + WS_H2); const bf16* WrT = (const bf16*)(p->ws + WS_WR);
    const int rt = F.wave >> 2, kq = F.wave & 3, l15 = F.lane & 15, lq = F.lane >> 4;
    const bf16* ap = H2 + (size_t)(row0 + 16 * rt + l15) * DM + kq * 1024 + 8 * lq;
    const bf16* bp0 = WrT + (size_t)l15 * DM + kq * 1024 + 8 * lq; const bf16* bp1 = bp0 + (size_t)16 * DM;
    f32x4v acc0 = {0.f, 0.f, 0.f, 0.f}, acc1 = acc0;
#pragma unroll 8
    for (int ks = 0; ks < 32; ++ks) { const bf16x8 a = *(const GAS bf16x8*)(ap + 32 * ks), b0 = *(const GAS bf16x8*)(bp0 + 32 * ks), b1 = *(const GAS bf16x8*)(bp1 + 32 * ks);
        acc0 = __builtin_amdgcn_mfma_f32_16x16x32_bf16(a, b0, acc0, 0, 0, 0); acc1 = __builtin_amdgcn_mfma_f32_16x16x32_bf16(a, b1, acc1, 0, 0, 0); }
    LAS float* red = (LAS float*)F.lds;
    __syncthreads();
#pragma unroll
    for (int i = 0; i < 4; ++i) { red[F.wave * 512 + (4 * lq + i) * 32 + l15] = acc0[i]; red[F.wave * 512 + (4 * lq + i) * 32 + 16 + l15] = acc1[i]; }
    __syncthreads();
    LAS float* lg = red + 4096;
    for (int t = F.tid; t < 1024; t += 512) { const int r = t >> 5, e = t & 31, rt2 = r >> 4; const LAS float* q = red + rt2 * 2048 + (r & 15) * 32 + e;
        lg[r * 33 + e] = (q[0] + q[512]) + (q[1024] + q[1536]) + p->router_b[e]; }
    __syncthreads();
    if (F.tid < 32) { const int r = F.tid; float val[4]; int idx[4]; unsigned used = 0u;
#pragma unroll
        for (int k = 0; k < 4; ++k) { float best = -__builtin_inff(); int bi = 0;
            for (int e = 0; e < 32; ++e) { const float x = lg[r * 33 + e]; if (!((used >> e) & 1u) && x > best) { best = x; bi = e; } }
            val[k] = best; idx[k] = bi; used |= 1u << bi; }
        float w[4], s = 0.f;
#pragma unroll
        for (int k = 0; k < 4; ++k) { w[k] = __builtin_amdgcn_exp2f((val[k] - val[0]) * LOG2E); s += w[k]; }
        const float inv = 1.f / s; const int tok = row0 + r;
        int* LIST = (int*)(p->ws + WS_LIST); float* GATE = (float*)(p->ws + WS_GATE); unsigned* cnt = (unsigned*)(p->ws + WS_CTL) + CW_CNT;
#pragma unroll
        for (int k = 0; k < 4; ++k) { const unsigned pos = atomicAdd(cnt + 64 * idx[k], 1u); LIST[idx[k] * NTOK + pos] = tok * 4 + k; GATE[tok * 4 + k] = w[k] * inv; } }
}

namespace pg8 {
struct MoeSched {
    const char* A; const char* Bt; size_t bstride_e; int lda, ldb, NT, G, c; LAS const int* tab; bool gather;
    __device__ __forceinline__ bool next(int i, Unit& u) const {
        const int TM = __builtin_amdgcn_readfirstlane(tab[64]); const int nwg = NT * TM; const long L = (long)i * G + c; if (L >= nwg) return false;
        const int wgid = xcd_remap((int)L, nwg); const int mtg = wgid / NT; u.pn = wgid - mtg * NT;
        int e = 0;
        for (int k = 1; k < NE; ++k) e += (__builtin_amdgcn_readfirstlane(tab[32 + k]) <= mtg) ? 1 : 0;
        u.e = e; u.pm = mtg - __builtin_amdgcn_readfirstlane(tab[32 + e]); u.aux = i; return true;
    }
    __device__ __forceinline__ const char* a_base(const Unit& u) const { return gather ? A : A + (size_t)(BM * (__builtin_amdgcn_readfirstlane(tab[32 + u.e]) + u.pm)) * lda * 2; }
    __device__ __forceinline__ const char* b_base(const Unit& u) const { return Bt + (size_t)u.e * bstride_e + (size_t)u.pn * BM * ldb * 2; }
    __device__ __forceinline__ int arow(const Unit& u, int pos) const { return gather ? tab[128 + 256 * u.aux + pos] : pos; }
};
struct EpiUp {
    static constexpr bool PERM = true;
    bf16* ACT; const float* b_up; LAS const int* tab;
    __device__ __forceinline__ void operator()(const f32x4 (&acc)[2][2][4][2], const Unit& u, int wr, int wc, int fr, int fq) const {
        const int seg = BM * tab[32 + u.e]; const int row0 = seg + u.pm * BM + wr * 64 + fr, jcol = 128 * u.pn + 32 * wc + 8 * fq;
        const float* bg = b_up + (size_t)u.e * (2 * DE) + jcol; const float* bu = bg + DE;
        const f32x4 bg0 = *(const GAS f32x4*)bg, bg1 = *(const GAS f32x4*)(bg + 4), bu0 = *(const GAS f32x4*)bu, bu1 = *(const GAS f32x4*)(bu + 4);
#pragma unroll
        for (int ai = 0; ai < 2; ++ai)
#pragma unroll
            for (int m = 0; m < 4; ++m) { bf16* rowp = ACT + (size_t)(row0 + ai * HALF + m * 16) * DE + jcol; float a[8];
#pragma unroll
                for (int n = 0; n < 2; ++n) { const f32x4 gv = acc[ai][0][m][n] + (n ? bg1 : bg0), uv = acc[ai][1][m][n] + (n ? bu1 : bu0);
#pragma unroll
                    for (int i = 0; i < 4; ++i) { const float g = fminf(gv[i], 7.f), uu = fminf(fmaxf(uv[i], -7.f), 7.f);
                        a[4 * n + i] = (uu + 1.f) * g / (1.f + __builtin_amdgcn_exp2f(-1.702f * LOG2E * g)); } }
                u32x4 w = {cvt_pk_bf16(a[0], a[1]), cvt_pk_bf16(a[2], a[3]), cvt_pk_bf16(a[4], a[5]), cvt_pk_bf16(a[6], a[7])};
                *(u32x4*)rowp = w; }
    }
};
struct EpiDown {
    static constexpr bool PERM = true;
    bf16* Y; const float* b_down; const int* LIST; const float* GATE; LAS const int* tab;
    __device__ __forceinline__ void operator()(const f32x4 (&acc)[2][2][4][2], const Unit& u, int wr, int wc, int fr, int fq) const {
        const int cnt = tab[u.e]; const int col0 = u.pn * BM + wc * 32 + 8 * fq; const float* bd = b_down + (size_t)u.e * DM + col0;
        f32x4 bv[2][2];
#pragma unroll
        for (int bj = 0; bj < 2; ++bj)
#pragma unroll
            for (int n = 0; n < 2; ++n) bv[bj][n] = *(const GAS f32x4*)(bd + bj * HALF + 4 * n);
#pragma unroll
        for (int ai = 0; ai < 2; ++ai)
#pragma unroll
            for (int m = 0; m < 4; ++m) { const int pos = u.pm * BM + ai * HALF + wr * 64 + m * 16 + fr;
                if (pos < cnt) { const int lv = LIST[(size_t)u.e * NTOK + pos]; const float gt = GATE[lv]; bf16* rowp = Y + (size_t)lv * DM + col0;
#pragma unroll
                    for (int bj = 0; bj < 2; ++bj) { const f32x4 v0 = (acc[ai][bj][m][0] + bv[bj][0]) * gt, v1 = (acc[ai][bj][m][1] + bv[bj][1]) * gt;
                        u32x4 w = {cvt_pk_bf16(v0[0], v0[1]), cvt_pk_bf16(v0[2], v0[3]), cvt_pk_bf16(v1[0], v1[1]), cvt_pk_bf16(v1[2], v1[3])};
                        *(u32x4*)(rowp + bj * HALF) = w; } } }
    }
};
}
__device__ __forceinline__ void moe_tables(Frame F, PP p, int NT, bool gather) {
    F.fresh();
    LAS int* tab = (LAS int*)(F.lds + LDSX_OFF); const unsigned* cnt = (const unsigned*)(p->ws + WS_CTL) + CW_CNT;
    __syncthreads();
    if (F.tid < NE) { unsigned c = __hip_atomic_load(cnt + 64 * F.tid, RLX_AGENT); tab[F.tid] = (int)(c > (unsigned)NTOK ? (unsigned)NTOK : c); }
    __syncthreads();
    if (F.tid == 0) { int s = 0; for (int e = 0; e < NE; ++e) { tab[32 + e] = s; s += (tab[e] + 255) >> 8; } tab[64] = s; }
    __syncthreads();
    if (gather) {
        const int TM = tab[64], nwg = NT * TM; const int* LIST = (const int*)(p->ws + WS_LIST);
        for (int i = 0; i < 10; ++i) { const long L = (long)i * F.G + (int)blockIdx.x; if (L >= nwg) break;
            const int wgid = pg8::xcd_remap((int)L, nwg), mtg = wgid / NT; int e = 0; for (int k = 1; k < NE; ++k) e += (tab[32 + k] <= mtg) ? 1 : 0;
            const int pm = mtg - tab[32 + e];
            if (F.tid < 256) { const int pos = pm * 256 + F.tid; tab[128 + 256 * i + F.tid] = (pos < tab[e]) ? (LIST[(size_t)e * NTOK + pos] >> 2) : 0; } }
        __syncthreads();
    }
}

constexpr int N_PHASES = 12;
__global__ void __launch_bounds__(512, 2) fwd_kernel(Params p_arg) {
    (void)p_arg; PP p = (PP)__builtin_amdgcn_kernarg_segment_ptr();
    extern __shared__ __attribute__((aligned(16))) unsigned char lds_raw[];
    Frame F;
    F.lds = (LAS unsigned char*)lds_raw; F.MISC = (volatile LAS unsigned*)(F.lds + MISC_OFF);
    F.tid = threadIdx.x; F.lane = F.tid & 63; F.wave = __builtin_amdgcn_readfirstlane(F.tid >> 6);
    F.G = gridDim.x; { const int bx = blockIdx.x; F.vcu = (F.G % 8 == 0) ? (bx % 8) * (F.G / 8) + bx / 8 : bx; }
    F.ctl = (gu32*)(p->ws + WS_CTL);
    for (int u = F.tid; u < (LDS_BYTES - MISC_OFF) / 4; u += 512) ((LAS unsigned*)(F.lds + MISC_OFF))[u] = 0u;
    __syncthreads();
    XcdBarrier bar; bar.bar = (unsigned*)(F.ctl + CW_BAR); bar.x = 0; bar.st = nullptr;
    if (!MK_PER_PHASE) bar = xcd_barrier_post((unsigned*)(F.ctl + CW_BAR), F.MISC + 8);
    const int lo = p->ph_lo, hi = p->ph_hi;
#ifndef PHMASK
#define PHMASK 0xFFF
#endif
#define IN(k) (((PHMASK >> (k)) & 1) && lo <= (k) && (k) < hi)
#define GRID_BAR(k) do { if (IN(k) && IN((k) + 1)) xcd_barrier(bar); } while (0)
    bf16* const WIN = (bf16*)(p->ws + WS_WIN); bf16* const WOUT = (bf16*)(p->ws + WS_WOUT); bf16* const WQ = (bf16*)(p->ws + WS_WQ); bf16* const WKV = (bf16*)(p->ws + WS_WKV);
    bf16* const WO = (bf16*)(p->ws + WS_WO); bf16* const WF = (bf16*)(p->ws + WS_WF); bf16* const WR = (bf16*)(p->ws + WS_WR); bf16* const WUP = (bf16*)(p->ws + WS_WUP); bf16* const WDN = (bf16*)(p->ws + WS_WDN);
    bf16* const H0 = (bf16*)(p->ws + WS_H0); bf16* const MEMN = (bf16*)(p->ws + WS_MEMN); bf16* const PB = (bf16*)(p->ws + WS_P); bf16* const OB = (bf16*)(p->ws + WS_O);
    float* const RB = (float*)(p->ws + WS_R); bf16* const H1 = (bf16*)(p->ws + WS_H1); bf16* const H2 = (bf16*)(p->ws + WS_H2); bf16* const OX = (bf16*)(p->ws + WS_OX);
    bf16* const ACT = (bf16*)(p->ws + WS_ACT); bf16* const YB = (bf16*)(p->ws + WS_Y);
    const int gw = F.vcu * 8 + F.wave, NGW = F.G * 8;

    if (IN(0)) {
        F.fresh(); P_FRESH(p);
        LAS float* scr = (LAS float*)(F.lds + F.wave * 16384);
        constexpr int I_A = 64 * 256, I_B = 64 * 192, I_C = 64 * 128, I_D = 64 * 16, I_E = 64 * 32, I_F = 8 * 128, I_G = 64, I_H = 32 * 64 * 64, I_I = 32 * 16 * 128;
        constexpr int NITEMS = I_A + I_B + I_C + I_D + I_E + I_F + I_G + I_H + I_I;
        for (int it = gw; it < NITEMS; it += NGW) {
            int r = it;
            if (r < I_A) { const int kb = r / 256, nb = r % 256; tr_item(p->w_in, N_IN_SRC, 64 * kb, 32 * nb, WIN, DM, 32 * nb, scr, F.lane); continue; } r -= I_A;
            if (r < I_B) { const int kb = r / 192, nb = r % 192; tr_item(p->w_in, N_IN_SRC, 64 * kb, 8208 + 32 * nb, WIN, DM, 8192 + 32 * nb, scr, F.lane); continue; } r -= I_B;
            if (r < I_C) { const int kb = r / 128, nb = r % 128; tr_item(p->w_out, DM, 64 * kb, 32 * nb, WOUT, DM, 32 * nb, scr, F.lane); continue; } r -= I_C;
            if (r < I_D) { const int kb = r / 16, nb = r % 16; tr_item(p->xa_wq, XW, 64 * kb, 32 * nb, WQ, DM, 32 * nb, scr, F.lane); continue; } r -= I_D;
            if (r < I_E) { const int kb = r / 32, nb = r % 32; tr_item(p->xa_wkv, 2 * XW, 64 * kb, 32 * nb, WKV, DM, 32 * nb, scr, F.lane); continue; } r -= I_E;
            if (r < I_F) { const int kb = r / 128, nb = r % 128; tr_item(p->xa_wo, DM, 64 * kb, 32 * nb, WO, XW, 32 * nb, scr, F.lane); continue; } r -= I_F;
            if (r < I_G) { tr_item(p->router_w, NE, 64 * r, 0, WR, DM, 0, scr, F.lane); continue; } r -= I_G;
            if (r < I_H) { const int e = r / 4096, q = r % 4096, kb = q / 64, nb = q % 64, t = nb >> 3, bj = (nb >> 2) & 1, qq = nb & 3;
                tr_item(p->w_up + (size_t)e * DM * (2 * DE), 2 * DE, 64 * kb, (bj ? DE : 0) + 128 * t + 32 * qq, WUP + (size_t)e * (2 * DE) * DM, DM, 32 * nb, scr, F.lane); continue; } r -= I_H;
            { const int e = r / 2048, q = r % 2048, kb = q / 128, nb = q % 128;
              tr_item(p->w_down + (size_t)e * DE * DM, DM, 64 * kb, 32 * nb, WDN + (size_t)e * DM * DE, DE, 32 * nb, scr, F.lane); }
        }
        for (int idx = (int)blockIdx.x * 512 + F.tid; idx < 16 * DM; idx += F.G * 512) { const int k = idx >> 4, n = idx & 15; WF[(size_t)n * DM + k] = (bf16)f2bf(p->w_in[(size_t)k * N_IN_SRC + 8192 + n]); }
        for (int m = gw; m < NTOK + NB * NMEM; m += NGW) {
            if (m < NTOK) ln_row_f32(p->x + (size_t)m * DM, p->ln_in_g, p->ln_in_b, H0 + (size_t)m * DM, F.lane);
            else ln_row_f32(p->mem + (size_t)(m - NTOK) * DM, p->mem_ln_g, p->mem_ln_b, MEMN + (size_t)(m - NTOK) * DM, F.lane); }
    }
    GRID_BAR(0);

    if (IN(1)) {
        F.fresh(); P_FRESH(p);
        pg8::DenseSched S; S.init(H0, WIN, DM, DM, NTOK, NP, F.G, (int)blockIdx.x);
        pg8::EpiBf16 E{PB, NP};
        pg8::gemm_phase<pg8::EpiBf16, pg8::DenseSched, true, false>(F.lds, DM, DM, DM, S, E);
        for (int rb = blockIdx.x; rb < NTOK / 32; rb += F.G) flogit_rows(F, p, 32 * rb);
    }
    GRID_BAR(1);

    if (IN(2)) {
        F.fresh(); P_FRESH(p);
        for (int pid = F.vcu; pid < 256; pid += F.G) {
            const int bh = pid >> 2, b = bh >> 4, h = bh & 15, q0 = pid & 3;
            fox_tables(F, p, b, h);
#pragma unroll 1
            for (int rep = 0; rep < 2; ++rep) attn_unit<0>(F, p, b, h, rep ? q0 : 7 - q0);
#pragma unroll 1
            for (int rep = 0; rep < 2; ++rep) attn_unit<1>(F, p, b, h, rep ? q0 : 7 - q0);
        }
    }
    GRID_BAR(2);

    if (IN(3)) {
        F.fresh(); P_FRESH(p);
        pg8::DenseSched S; S.init(OB, WOUT, DM, DM, NTOK, DM, F.G, (int)blockIdx.x);
        pg8::EpiRes E{RB, H0, DM, DN_ALPHA};
        pg8::gemm_phase<pg8::EpiRes, pg8::DenseSched, true, false>(F.lds, DM, DM, DM, S, E);
    }
    GRID_BAR(3);

    if (IN(4)) {
        F.fresh(); P_FRESH(p);
        const int nkv = (F.G >= 128) ? 64 : 0;
        if ((int)blockIdx.x < nkv || nkv == 0) {
            for (int c = blockIdx.x; c < 64; c += (nkv ? 64 : F.G)) {
                pg8::SplitKSched S{(const char*)MEMN, (const char*)WKV, DM, DM, 4, 4, QSPLIT, QKS, c};
                pg8::EpiSlab E{(float*)(p->ws + WS_KVS), 2 * XW, (size_t)NB * NMEM * 2 * XW};
                pg8::gemm_phase<pg8::EpiSlab, pg8::SplitKSched, false, false>(F.lds, QKS, DM, DM, S, E);
                if (nkv) break;
            }
        }
        if ((int)blockIdx.x >= nkv) { const int nw = (F.G - nkv) * 8, w0 = ((int)blockIdx.x - nkv) * 8 + F.wave;
            for (int m = w0; m < NTOK; m += nw) ln_row_f32(RB + (size_t)m * DM, p->ln_mix_g, p->ln_mix_b, H1 + (size_t)m * DM, F.lane); }
    }
    GRID_BAR(4);

    if (IN(5)) {
        F.fresh(); P_FRESH(p);
        for (int c = blockIdx.x; c < 256; c += F.G) {
            pg8::SplitKSched S{(const char*)H1, (const char*)WQ, DM, DM, NTOK / 256, 2, QSPLIT, QKS, c};
            pg8::EpiSlab E{(float*)(p->ws + WS_QS), XW, (size_t)NTOK * XW};
            pg8::gemm_phase<pg8::EpiSlab, pg8::SplitKSched, false, false>(F.lds, QKS, DM, DM, S, E);
        }
    }
    GRID_BAR(5);

    if (IN(6)) {
        F.fresh(); P_FRESH(p);
        for (int u = F.vcu; u < 256; u += F.G) xattn_unit(F, p, u >> 6, (u >> 4) & 3, u & 15);
    }
    GRID_BAR(6);

    if (IN(7)) {
        F.fresh(); P_FRESH(p);
        pg8::DenseSched S; S.init(OX, WO, XW, XW, NTOK, DM, F.G, (int)blockIdx.x);
        pg8::EpiRes E{RB, H1, DM, DN_ALPHA};
        pg8::gemm_phase<pg8::EpiRes, pg8::DenseSched, true, false>(F.lds, XW, XW, XW, S, E);
    }
    GRID_BAR(7);

    if (IN(8)) {
        F.fresh(); P_FRESH(p);
        for (int rb = blockIdx.x; rb < NTOK / 32; rb += F.G) {
            for (int i = 0; i < 4; ++i) { const int m = 32 * rb + 4 * F.wave + i; ln_row_f32(RB + (size_t)m * DM, p->ln_xa_g, p->ln_xa_b, H2 + (size_t)m * DM, F.lane); }
            VM_WAIT(); __syncthreads();
            if (F.wave == 0) { __builtin_amdgcn_fence(__ATOMIC_RELEASE, "agent"); __builtin_amdgcn_fence(__ATOMIC_ACQUIRE, "agent"); VM_WAIT(); }
            __syncthreads();
            router_rows(F, p, 32 * rb);
        }
    }
    GRID_BAR(8);

    if (IN(9)) {
        F.fresh(); P_FRESH(p);
        moe_tables(F, p, 8, true);
        LAS const int* tab = (LAS const int*)(F.lds + LDSX_OFF);
        pg8::MoeSched S{(const char*)H2, (const char*)WUP, (size_t)(2 * DE) * DM * 2, DM, DM, 8, F.G, (int)blockIdx.x, tab, true};
        pg8::EpiUp E{ACT, p->b_up, tab};
        pg8::gemm_phase<pg8::EpiUp, pg8::MoeSched, true, true>(F.lds, DM, DM, DM, S, E);
    }
    GRID_BAR(9);

    if (IN(10)) {
        F.fresh(); P_FRESH(p);
        moe_tables(F, p, 16, false);
        LAS const int* tab = (LAS const int*)(F.lds + LDSX_OFF);
        pg8::MoeSched S{(const char*)ACT, (const char*)WDN, (size_t)DM * DE * 2, DE, DE, 16, F.G, (int)blockIdx.x, tab, false};
        pg8::EpiDown E{YB, p->b_down, (const int*)(p->ws + WS_LIST), (const float*)(p->ws + WS_GATE), tab};
        pg8::gemm_phase<pg8::EpiDown, pg8::MoeSched, true, false>(F.lds, DE, DE, DE, S, E);
    }
    GRID_BAR(10);

    if (IN(11)) {
        F.fresh(); P_FRESH(p);
        unsigned bad = __hip_atomic_load(F.ctl + CW_BAR + XB_TMO, RLX_AGENT);
        for (int m = gw; m < NTOK; m += NGW) {
            f32x4 v[16];
#pragma unroll
            for (int j = 0; j < 16; ++j) { const u32x2 hh = ((const GAS u32x2*)(H2 + (size_t)m * DM))[F.lane + 64 * j];
                f32x4 a = {DN_ALPHA * bflo(hh.x), DN_ALPHA * bfhi(hh.x), DN_ALPHA * bflo(hh.y), DN_ALPHA * bfhi(hh.y)};
#pragma unroll
                for (int k = 0; k < 4; ++k) { const u32x2 yy = ((const GAS u32x2*)(YB + ((size_t)m * 4 + k) * DM))[F.lane + 64 * j]; a[0] += bflo(yy.x); a[1] += bfhi(yy.x); a[2] += bflo(yy.y); a[3] += bfhi(yy.y); }
                v[j] = a; }
            if (bad) v[0][0] = __builtin_nanf("");
            ln_row_store(v, p->ln_moe_g, p->ln_moe_b, nullptr, p->out + (size_t)m * DM, F.lane);
        }
    }
#undef IN
#undef GRID_BAR
}

extern "C" void kernel_launch(void* const* d_in, const int* in_sizes, int n_in, void* d_out, int out_size, void* d_ws, size_t ws_size, hipStream_t stream) {
    static int grid = 0;
    if (grid == 0) {
        if (n_in != 27 || out_size != NTOK * DM || ws_size < WS_END) { fprintf(stderr, "kernel_launch: unexpected problem shape (n_in %d, out %d, ws %zu)\n", n_in, out_size, ws_size); grid = -1; return; }
        int dev = 0, cus = 0, per_cu = 0;
        if (hipGetDevice(&dev) != hipSuccess || hipDeviceGetAttribute(&cus, hipDeviceAttributeMultiprocessorCount, dev) != hipSuccess) { grid = -1; return; }
        if (hipFuncSetAttribute((const void*)fwd_kernel, hipFuncAttributeMaxDynamicSharedMemorySize, LDS_BYTES) != hipSuccess) { fprintf(stderr, "kernel_launch: hipFuncSetAttribute failed\n"); grid = -1; return; }
        if (hipOccupancyMaxActiveBlocksPerMultiprocessor(&per_cu, (const void*)fwd_kernel, 512, LDS_BYTES) != hipSuccess || per_cu < 1) fprintf(stderr, "kernel_launch: occupancy query reports %d blocks per CU\n", per_cu);
        (void)hipGetLastError();
        grid = cus;
    }
    if (grid < 0) return;
    (void)hipMemsetAsync((char*)d_ws + WS_CTL, 0, CTL_ZERO_BYTES, stream);
    Params p{};
    const float** pp = (const float**)&p;
    for (int i = 0; i < 27; ++i) pp[i] = (const float*)d_in[i];
    p.out = (float*)d_out; p.ws = (unsigned char*)d_ws;
#if MK_PER_PHASE
    for (int k = 0; k < N_PHASES; ++k) { p.ph_lo = k; p.ph_hi = k + 1; hipLaunchKernelGGL(fwd_kernel, dim3(grid), dim3(512), LDS_BYTES, stream, p); }
#else
    p.ph_lo = 0; p.ph_hi = N_PHASES;
    hipLaunchKernelGGL(fwd_kernel, dim3(grid), dim3(512), LDS_BYTES, stream, p);
#endif
}
```

```cpp
#include <hip/hip_runtime.h>
#include <cstdio>
#include <cstdint>

#ifndef PROBE_REP
#define PROBE_REP -1
#endif
#ifndef MK_PER_PHASE
#define MK_PER_PHASE 0
#endif

#define GAS __attribute__((address_space(1)))
#define LAS __attribute__((address_space(3)))
typedef unsigned short bf16;
typedef short bf16x8 __attribute__((ext_vector_type(8)));
typedef short s16x4 __attribute__((ext_vector_type(4)));
typedef short v4i16_t __attribute__((ext_vector_type(4)));
typedef float f32x4 __attribute__((ext_vector_type(4)));
typedef float f32x2 __attribute__((ext_vector_type(2)));
typedef float f32x16 __attribute__((ext_vector_type(16)));
typedef unsigned u32x4 __attribute__((ext_vector_type(4)));
typedef unsigned u32x2 __attribute__((ext_vector_type(2)));
typedef int v8i __attribute__((ext_vector_type(8)));
typedef int v4i __attribute__((ext_vector_type(4)));
typedef GAS unsigned gu32;
#define RLX_AGENT __ATOMIC_RELAXED, __HIP_MEMORY_SCOPE_AGENT
#define LDS_WAIT() asm volatile("s_waitcnt lgkmcnt(0)" ::: "memory")
#define VM_WAIT() asm volatile("s_waitcnt vmcnt(0)" ::: "memory")
#define SBAR() __builtin_amdgcn_sched_barrier(0)

constexpr int NB = 4, SEQ = 2048, DM = 4096, NTOK = NB * SEQ, HD = 128, NFH = 16, NSH = 16;
constexpr int NP = 14336;
constexpr int PC_QF = 0, PC_KF = 2048, PC_VF = 4096, PC_GF = 6144, PC_QS = 8192, PC_KS = 10240, PC_VS = 12288;
constexpr int N_IN_SRC = 14352;
constexpr int NMEM = 256, XH = 4, XW = 512;
constexpr int NE = 32, TOPK = 4, DE = 1024;
constexpr float LN_EPS = 1e-5f, RMS_EPS = 1e-6f;
constexpr float DN_ALPHA = 1.189207115002721f;
constexpr float LOG2E = 1.4426950408889634f;
constexpr float C2 = 0.08838834764831845f * 1.4426950408889634f;
constexpr int QSPLIT = 4, QKS = DM / QSPLIT;

constexpr size_t MiB = 1u << 20;
constexpr size_t WS_CTL = 0, CTL_ZERO_BYTES = 1 * MiB;
constexpr size_t WS_WIN = 16 * MiB;
constexpr size_t WS_WOUT = 128 * MiB;
constexpr size_t WS_WQ = 160 * MiB, WS_WKV = 164 * MiB, WS_WO = 172 * MiB, WS_WF = 176 * MiB, WS_WR = 177 * MiB;
constexpr size_t WS_WUP = 192 * MiB;
constexpr size_t WS_H2F8 = 448 * MiB;
constexpr size_t WS_WDN = 704 * MiB;
constexpr size_t WS_H0 = 960 * MiB, WS_MEMN = 1024 * MiB;
constexpr size_t WS_P = 1040 * MiB;
constexpr size_t WS_FL = 1264 * MiB;
constexpr size_t WS_O = 1272 * MiB;
constexpr size_t WS_R = 1336 * MiB;
constexpr size_t WS_H1 = 1464 * MiB;
constexpr size_t WS_KVS = 1528 * MiB;
constexpr size_t WS_QS = 1544 * MiB;
constexpr size_t WS_OX = 1608 * MiB;
constexpr size_t WS_H2 = 1616 * MiB;
constexpr size_t WS_LIST = 1680 * MiB;
constexpr size_t WS_GATE = 1682 * MiB;
constexpr size_t WS_KVB = 1684 * MiB;
constexpr size_t WS_ACT = 1688 * MiB;
constexpr size_t WS_Y = 1768 * MiB;
constexpr size_t WS_END = 2024 * MiB;
constexpr int CW_TMO = 0;
constexpr int CW_BAR = 4096;
constexpr int CW_CNT = 65536;

constexpr int RING_BYTES = 131072;
constexpr int LDSX_OFF = RING_BYTES;
constexpr int MISC_OFF = RING_BYTES + 12288;
constexpr int LDS_BYTES = 147456;

__device__ __forceinline__ unsigned f2bf(float f) { unsigned u = __builtin_bit_cast(unsigned, f); return (u + 0x7fffu + ((u >> 16) & 1u)) >> 16; }
__device__ __forceinline__ unsigned pk2(float lo, float hi) { return f2bf(lo) | (f2bf(hi) << 16); }
__device__ __forceinline__ float bf2f(unsigned short b) { return __builtin_bit_cast(float, (unsigned)b << 16); }
__device__ __forceinline__ float bflo(unsigned w) { return __builtin_bit_cast(float, w << 16); }
__device__ __forceinline__ float bfhi(unsigned w) { return __builtin_bit_cast(float, w & 0xffff0000u); }
__device__ __forceinline__ unsigned cvt_pk_bf16(float lo, float hi) { unsigned r; asm volatile("v_cvt_pk_bf16_f32 %0, %1, %2" : "=v"(r) : "v"(lo), "v"(hi)); return r; }
constexpr float F8S_H2 = 16.f, F8S_W = 1024.f, F8S_ACT = 4.f;
constexpr int E8_H2 = 0x7B7B7B7B, E8_W = 0x75757575, E8_ACT = 0x7D7D7D7D;
__device__ __forceinline__ unsigned pk4_fp8(float a, float b, float c, float d) { int w = 0; w = __builtin_amdgcn_cvt_pk_fp8_f32(a, b, w, false); w = __builtin_amdgcn_cvt_pk_fp8_f32(c, d, w, true); return (unsigned)w; }
__device__ __forceinline__ float wave_sum(float v) {
#pragma unroll
    for (int o = 1; o < 64; o <<= 1) v += __shfl_xor(v, o);
    return v;
}

#define XB_TMO      128
#define XB_XCNT(j)  (256  + 64 * (j))
#define XB_XSUB(j)  (1280 + 64 * (j))
#define XB_XGEN(j)  (2304 + 64 * (j))
#define XB_TOP      3328
#define XB_TOPGEN   3392
#define XCD_BAR_WORDS 3456
#define XB_SPIN_CAP (1u << 18)
__device__ __forceinline__ unsigned xb_ld(unsigned* p)              { return __hip_atomic_load(p, __ATOMIC_RELAXED, __HIP_MEMORY_SCOPE_AGENT); }
__device__ __forceinline__ unsigned xb_add(unsigned* p, unsigned v) { return __hip_atomic_fetch_add(p, v, __ATOMIC_RELAXED, __HIP_MEMORY_SCOPE_AGENT); }
__device__ __forceinline__ unsigned xb_xcc_id() { return (unsigned)__builtin_amdgcn_s_getreg((3 << 11) | 20) & 0xFu; }
#define XB_SPIN(cond, bar) do { unsigned _sp = 0; while (cond) { __builtin_amdgcn_s_sleep(1); \
    if ((++_sp & 255u) == 0u) { if (xb_ld(&(bar)[XB_TMO])) break; if (_sp > XB_SPIN_CAP) { atomicAdd(&(bar)[XB_TMO], 1u); break; } } } } while (0)
struct XcdBarrier { unsigned* bar; unsigned x; volatile LAS unsigned* st; };
__device__ __forceinline__ XcdBarrier xcd_barrier_post(unsigned* bar, volatile LAS unsigned* st) {
    XcdBarrier b; b.bar = bar; b.x = xb_xcc_id(); b.st = st;
    if (threadIdx.x == 0) (void)xb_add(&bar[XB_XCNT(b.x)], 1u);
    return b;
}
__device__ __forceinline__ void xcd_barrier_complete(unsigned* bar, unsigned x, unsigned& nloc, unsigned& nx) {
    const unsigned G = gridDim.x * gridDim.y * gridDim.z;
    unsigned sum, cnt, mine, sp = 0u;
    for (;;) {
        sum = 0u; cnt = 0u; mine = 0u;
#pragma unroll
        for (unsigned j = 0; j < 16; ++j) { const unsigned c = xb_ld(&bar[XB_XCNT(j)]); sum += c; cnt += (c > 0u) ? 1u : 0u; mine = (j == x) ? c : mine; }
        if (sum == G) break;
        __builtin_amdgcn_s_sleep(1);
        if ((++sp & 255u) == 0u) { if (xb_ld(&bar[XB_TMO])) break; if (sp > XB_SPIN_CAP) { atomicAdd(&bar[XB_TMO], 1u); break; } }
    }
    nloc = mine > 0u ? mine : 1u; nx = cnt > 0u ? cnt : 1u;
}
__device__ __forceinline__ void xcd_barrier(const XcdBarrier& b) {
    asm volatile("s_waitcnt vmcnt(0)" ::: "memory");
    __syncthreads();
    if (threadIdx.x == 0) {
        unsigned* bar = b.bar;
        __builtin_amdgcn_s_waitcnt(0);
        unsigned nloc = b.st[0], nx = b.st[1];
        if (nloc == 0u) { xcd_barrier_complete(bar, b.x, nloc, nx); b.st[0] = nloc; b.st[1] = nx; }
        const unsigned old = xb_add(&bar[XB_XSUB(b.x)], 1u);
        const unsigned gen = old / nloc;
        if (old + 1u == (gen + 1u) * nloc) {
            __builtin_amdgcn_fence(__ATOMIC_RELEASE, "agent");
            asm volatile("s_waitcnt vmcnt(0)" ::: "memory");
            const unsigned og = xb_add(&bar[XB_TOP], 1u);
            const unsigned tg = og / nx;
            if (og + 1u == (tg + 1u) * nx) xb_add(&bar[XB_TOPGEN], 1u);
            else XB_SPIN(xb_ld(&bar[XB_TOPGEN]) == tg, bar);
            __builtin_amdgcn_fence(__ATOMIC_ACQUIRE, "agent");
            xb_add(&bar[XB_XGEN(b.x)], 1u);
            asm volatile("s_waitcnt vmcnt(0)" ::: "memory");
        } else {
            XB_SPIN(xb_ld(&bar[XB_XGEN(b.x)]) == gen, bar);
            __builtin_amdgcn_fence(__ATOMIC_ACQUIRE, "agent");
            asm volatile("s_waitcnt vmcnt(0)" ::: "memory");
        }
    }
    __syncthreads();
}

namespace pg8 {
constexpr int BM = 256, BK = 64, HALF = 128, HTB = HALF * BK * 2, NXCD = 8, WGM = 8;
__host__ __device__ __forceinline__ int lds_byte(int r, int c) { const int st = (r >> 4) * 2 + (c >> 5), rr = r & 15, cc = c & 31, ob = rr * 64 + cc * 2; return st * 1024 + (ob ^ (((ob >> 9) & 1) << 5)); }
__host__ __device__ __forceinline__ void stage_rc(int b, int& R, int& C) { const int st = b / 1024, sb = b % 1024, swz = sb ^ (((sb >> 9) & 1) << 5); R = (st >> 1) * 16 + swz / 64; C = (st & 1) * 32 + (swz % 64) / 2; }
__host__ __device__ __forceinline__ int perm32(int rho) { const int n = rho >> 4, i = rho & 15; return 8 * (i >> 2) + 4 * n + (i & 3); }
__device__ __forceinline__ int xcd_remap(int L, int nwg) { const int q = nwg / NXCD, r = nwg % NXCD, xcd = L % NXCD, off = L / NXCD; return (xcd < r ? xcd * (q + 1) : r * (q + 1) + (xcd - r) * q) + off; }

struct Unit { int pm, pn, e, aux; };

struct DenseSched {
    const char* A; const char* Bt; int lda, ldb, nM, nN, nwg, G, c, ib, ie;
    __device__ void init(const void* A_, const void* Bt_, int lda_, int ldb_, int M, int N, int G_, int c_) { A = (const char*)A_; Bt = (const char*)Bt_; lda = lda_; ldb = ldb_; nM = M / BM; nN = N / BM; nwg = nM * nN; G = G_; c = c_; ib = 0; ie = 1 << 30; }
    __device__ __forceinline__ bool next(int i0, Unit& u) const {
        const int i = i0 + ib; if (i >= ie) return false;
        const long L = (long)i * G + c; if (L >= nwg) return false;
        const int wgid = xcd_remap((int)L, nwg);
        const int nig = WGM * nN, gid = wgid / nig, fm = gid * WGM, gsz = (nM - fm) < WGM ? (nM - fm) : WGM;
        u.pm = fm + ((wgid % nig) % gsz); u.pn = (wgid % nig) / gsz; u.e = 0; u.aux = i; return true;
    }
    __device__ __forceinline__ int a_off(const Unit& u) const { return u.pm * BM * lda; }
    __device__ __forceinline__ int b_off(const Unit& u) const { return u.pn * BM * ldb; }
    __device__ __forceinline__ int arow(const Unit&, int pos) const { return pos; }
};
struct SplitKSched {
    const char* A; const char* Bt; int lda, ldb, nM, nN, nS, ks, c;
    __device__ __forceinline__ bool next(int i, Unit& u) const {
        if (i > 0 || c < 0 || c >= nM * nN * nS) return false;
        u.e = c % nS; const int t = c / nS; u.pn = t % nN; u.pm = t / nN; u.aux = 0; return true;
    }
    __device__ __forceinline__ int a_off(const Unit& u) const { return u.pm * BM * lda + u.e * ks * 2; }
    __device__ __forceinline__ int b_off(const Unit& u) const { return u.pn * BM * ldb + u.e * ks * 2; }
    __device__ __forceinline__ int arow(const Unit&, int pos) const { return pos; }
};

template <class Epi, class Sched, bool ALIGN_EPI, bool GATHER, bool FP8 = false>
__device__ __forceinline__ void gemm_phase(LAS unsigned char* lds, const int KB, const int lda, const int ldb, const Sched& S, const Epi& E, const int sclA = 0x7F7F7F7F, const int sclB = 0x7F7F7F7F) {
    int tid_ = threadIdx.x; asm volatile("" : "+v"(tid_));
    const int tid = tid_, wid = __builtin_amdgcn_readfirstlane(tid >> 6), lane = tid & 63, wr = wid >> 2, wc = wid & 3, fr = lane & 15, fq = lane >> 4;
    const int nt = KB / (BK * 2);
    int R0, C0; stage_rc(tid * 16, R0, C0);
    unsigned voffB[2];
    { const int R1 = R0 + 64; const int Rb0 = Epi::PERM ? ((R0 & ~31) + perm32(R0 & 31)) : R0, Rb1 = Epi::PERM ? ((R1 & ~31) + perm32(R1 & 31)) : R1;
      voffB[0] = (unsigned)(Rb0 * ldb + C0 * 2); voffB[1] = (unsigned)(Rb1 * ldb + C0 * 2); }
    const int kstep = BK * 2;
    const int hstepB = HALF * ldb;
    const __amdgpu_buffer_rsrc_t rsA = __builtin_amdgcn_make_buffer_rsrc((void*)S.A, (short)0, (int)0xFFFFFFFFu, 0x00020000);
    const __amdgpu_buffer_rsrc_t rsB = __builtin_amdgcn_make_buffer_rsrc((void*)S.Bt, (short)0, (int)0xFFFFFFFFu, 0x00020000);
    const unsigned ldsw = (unsigned)wid * 1024u;
    const int aoff = lds_byte(wr * 64 + fr, fq * 8), boff = lds_byte(wc * 32 + fr, fq * 8);
#define PG8_SA(b, h) (((b) * 2 + (h)) * HTB)
#define PG8_SB(b, h) ((4 + (b) * 2 + (h)) * HTB)
#define PG8_ST2(bufoff, rs, soff, o0, o1) do { const int so_ = (soff); \
        __builtin_amdgcn_raw_ptr_buffer_load_lds(rs, (LAS unsigned*)(lds + (bufoff) + ldsw), 16, (int)(o0), so_, 0, 0); \
        __builtin_amdgcn_raw_ptr_buffer_load_lds(rs, (LAS unsigned*)(lds + (bufoff) + ldsw + 8192), 16, (int)(o1), so_, 0, 0); } while (0)
#define PG8_STB(b, h, soff) PG8_ST2(PG8_SB(b, h), rsB, (soff) + (h) * hstepB, voffB[0], voffB[1])
#define PG8_STA(b, h, soff, V) PG8_ST2(PG8_SA(b, h), rsA, (soff), V[2 * (h)], V[2 * (h) + 1])
#define PG8_LDA(dst, b, h) do { _Pragma("unroll") for (int m = 0; m < 4; ++m) { if constexpr (FP8) { \
            dst##8[m] = __builtin_shufflevector(*(const LAS v4i*)(lds + PG8_SA(b, h) + aoff + m * 2048), *(const LAS v4i*)(lds + PG8_SA(b, h) + aoff + m * 2048 + 1024), 0, 1, 2, 3, 4, 5, 6, 7); } \
        else { _Pragma("unroll") for (int k = 0; k < 2; ++k) dst[m][k] = *(const LAS bf16x8*)(lds + PG8_SA(b, h) + aoff + m * 2048 + k * 1024); } } } while (0)
#define PG8_LDB(dst, b, h) do { _Pragma("unroll") for (int n = 0; n < 2; ++n) { if constexpr (FP8) { \
            dst##8[n] = __builtin_shufflevector(*(const LAS v4i*)(lds + PG8_SB(b, h) + boff + n * 2048), *(const LAS v4i*)(lds + PG8_SB(b, h) + boff + n * 2048 + 1024), 0, 1, 2, 3, 4, 5, 6, 7); } \
        else { _Pragma("unroll") for (int k = 0; k < 2; ++k) dst[n][k] = *(const LAS bf16x8*)(lds + PG8_SB(b, h) + boff + n * 2048 + k * 1024); } } } while (0)
#define PG8_MMA(ai, bj, At, Bt) do { __builtin_amdgcn_s_setprio(1); _Pragma("unroll") for (int m = 0; m < 4; ++m) _Pragma("unroll") for (int n = 0; n < 2; ++n) { \
        if constexpr (FP8) { asm volatile("v_mfma_scale_f32_16x16x128_f8f6f4 %0, %1, %2, %0, %3, %4 op_sel_hi:[0,0,0]" : "+v"(acc[ai][bj][m][n]) : "v"(Bt##8[n]), "v"(At##8[m]), "v"(sclB), "v"(sclA)); }   \
        else { _Pragma("unroll") for (int k = 0; k < 2; ++k) acc[ai][bj][m][n] = __builtin_amdgcn_mfma_f32_16x16x32_bf16(Bt[n][k], At[m][k], acc[ai][bj][m][n], 0, 0, 0); } } \
        __builtin_amdgcn_s_setprio(0); } while (0)
#define PG8_WAIT_V(n) asm volatile("s_waitcnt vmcnt(" #n ")" ::: "memory")
#define PG8_WAIT_L(n) asm volatile("s_waitcnt lgkmcnt(" #n ")" ::: "memory")
#define PG8_BAR __builtin_amdgcn_s_barrier()
#define PG8_SCHED __builtin_amdgcn_sched_barrier(0)
    Unit cur, nxt; int ui = 0;
    if (!S.next(0, cur)) return;
    unsigned vA[4], vAn[4];
#pragma unroll
    for (int j = 0; j < 4; ++j) { const int pos = (j >> 1) * HALF + R0 + (j & 1) * 64; vA[j] = (unsigned)(S.arow(cur, pos) * lda + C0 * 2); vAn[j] = vA[j]; }
    f32x4 acc[2][2][4][2];
#pragma unroll
    for (int a = 0; a < 2; ++a)
#pragma unroll
        for (int b = 0; b < 2; ++b)
#pragma unroll
            for (int m = 0; m < 4; ++m)
#pragma unroll
                for (int n = 0; n < 2; ++n) acc[a][b][m][n] = (f32x4){0.f, 0.f, 0.f, 0.f};
    bf16x8 At[4][2], B0[2][2], B1[2][2]; v8i At8[4], B08[2], B18[2];
    int cA = __builtin_amdgcn_readfirstlane(S.a_off(cur)), cB = __builtin_amdgcn_readfirstlane(S.b_off(cur));
    PG8_STB(0, 0, cB); PG8_STB(0, 1, cB); PG8_STA(0, 0, cA, vA); PG8_STA(0, 1, cA, vA);
    if (wr == 1) PG8_BAR;
    PG8_WAIT_V(2); PG8_BAR;
    PG8_STB(1, 0, cB + kstep); PG8_STA(1, 0, cA + kstep, vA); PG8_STB(1, 1, cB + kstep);
    PG8_WAIT_V(6); PG8_BAR;
    for (;;) {
        const bool has_next = S.next(ui + 1, nxt);
        const int nA = __builtin_amdgcn_readfirstlane(has_next ? S.a_off(nxt) : cA), nB = __builtin_amdgcn_readfirstlane(has_next ? S.b_off(nxt) : cB);
        if (GATHER) {
#pragma unroll
            for (int j = 0; j < 4; ++j) { const int pos = (j >> 1) * HALF + R0 + (j & 1) * 64; vAn[j] = has_next ? (unsigned)(S.arow(nxt, pos) * lda + C0 * 2) : vA[j]; }
        }
#pragma unroll 1
        for (int t = 0; t < nt; t += 2) {
            const bool last = (t == nt - 2);
            const int a1 = cA + (t + 1) * kstep;
            const int a2 = last ? nA : cA + (t + 2) * kstep, b2 = last ? nB : cB + (t + 2) * kstep;
            const int a3 = a2 + kstep, b3 = b2 + kstep;
            unsigned vX[4];
#pragma unroll
            for (int j = 0; j < 4; ++j) vX[j] = (GATHER && last) ? vAn[j] : vA[j];
            PG8_LDB(B0, 0, 0); PG8_LDB(B1, 0, 1); PG8_SCHED; PG8_LDA(At, 0, 0); PG8_STA(1, 1, a1, vA);
            PG8_WAIT_V(8); PG8_WAIT_L(0); PG8_BAR; PG8_MMA(0, 0, At, B0); PG8_MMA(0, 1, At, B1); PG8_BAR; PG8_SCHED;
            PG8_LDA(At, 0, 1); PG8_STB(0, 0, b2); PG8_STB(0, 1, b2); PG8_STA(0, 0, a2, vX);
            PG8_WAIT_V(8); PG8_WAIT_L(0); PG8_BAR; PG8_MMA(1, 0, At, B0); PG8_MMA(1, 1, At, B1); PG8_BAR; PG8_SCHED;
            PG8_LDB(B0, 1, 0); PG8_LDB(B1, 1, 1); PG8_SCHED; PG8_LDA(At, 1, 0); PG8_STA(0, 1, a2, vX);
            PG8_WAIT_V(8); PG8_WAIT_L(0); PG8_BAR; PG8_MMA(0, 0, At, B0); PG8_MMA(0, 1, At, B1); PG8_BAR; PG8_SCHED;
            PG8_LDA(At, 1, 1); PG8_STB(1, 0, b3); PG8_STB(1, 1, b3); PG8_STA(1, 0, a3, vX);
            PG8_WAIT_V(8); PG8_WAIT_L(0); PG8_BAR; PG8_MMA(1, 0, At, B0); PG8_MMA(1, 1, At, B1); PG8_BAR; PG8_SCHED;
        }
        if constexpr (ALIGN_EPI) { if (wr == 0) PG8_BAR; }
        if constexpr (FP8) asm volatile("s_nop 15\n\ts_nop 15\n\ts_nop 15" ::: "memory");
        { const int lane2 = __builtin_amdgcn_mbcnt_hi(~0u, __builtin_amdgcn_mbcnt_lo(~0u, 0u));
          int fr_ = lane2 & 15, fq_ = lane2 >> 4, wr_ = wr, wc_ = wc; asm volatile("" : "+v"(fr_), "+v"(fq_), "+s"(wr_), "+s"(wc_));
          E(acc, cur, wr_, wc_, fr_, fq_); }
        if (!has_next) break;
#pragma unroll
        for (int a = 0; a < 2; ++a)
#pragma unroll
            for (int b = 0; b < 2; ++b)
#pragma unroll
                for (int m = 0; m < 4; ++m)
#pragma unroll
                    for (int n = 0; n < 2; ++n) acc[a][b][m][n] = (f32x4){0.f, 0.f, 0.f, 0.f};
        cur = nxt; cA = nA; cB = nB; ++ui;
        if (GATHER) {
#pragma unroll
            for (int j = 0; j < 4; ++j) vA[j] = vAn[j];
        }
        if constexpr (ALIGN_EPI) { if (wr == 1) PG8_BAR; }
    }
    PG8_WAIT_V(0);
    if constexpr (!ALIGN_EPI) { if (wr == 0) PG8_BAR; }
    PG8_BAR;
#undef PG8_SA
#undef PG8_SB
#undef PG8_ST2
#undef PG8_STB
#undef PG8_STA
#undef PG8_LDA
#undef PG8_LDB
#undef PG8_MMA
#undef PG8_WAIT_V
#undef PG8_WAIT_L
#undef PG8_BAR
#undef PG8_SCHED
}

struct EpiBf16 {
    static constexpr bool PERM = true;
    bf16* O; int ldc;
    __device__ __forceinline__ void operator()(const f32x4 (&acc)[2][2][4][2], const Unit& u, int wr, int wc, int fr, int fq) const {
        const int row0 = u.pm * BM + wr * 64 + fr, col0 = u.pn * BM + wc * 32 + 8 * fq;
#pragma unroll
        for (int ai = 0; ai < 2; ++ai)
#pragma unroll
            for (int m = 0; m < 4; ++m) { bf16* rowp = O + (size_t)(row0 + ai * HALF + m * 16) * ldc + col0;
#pragma unroll
                for (int bj = 0; bj < 2; ++bj) { const f32x4 v0 = acc[ai][bj][m][0], v1 = acc[ai][bj][m][1];
                    u32x4 w; w.x = cvt_pk_bf16(v0[0], v0[1]); w.y = cvt_pk_bf16(v0[2], v0[3]); w.z = cvt_pk_bf16(v1[0], v1[1]); w.w = cvt_pk_bf16(v1[2], v1[3]);
                    *(u32x4*)(rowp + bj * HALF) = w; } }
    }
};
struct EpiRes {
    static constexpr bool PERM = false;
    float* C; const bf16* res; int ldc; float alpha;
    __device__ __forceinline__ void operator()(const f32x4 (&acc)[2][2][4][2], const Unit& u, int wr, int wc, int fr, int fq) const {
        const int row0 = u.pm * BM + wr * 64 + fr, col0 = u.pn * BM + wc * 32 + 4 * fq;
#pragma unroll
        for (int ai = 0; ai < 2; ++ai)
#pragma unroll
            for (int m = 0; m < 4; ++m) { const size_t off = (size_t)(row0 + ai * HALF + m * 16) * ldc + col0;
#pragma unroll
                for (int bj = 0; bj < 2; ++bj)
#pragma unroll
                    for (int n = 0; n < 2; ++n) { const u32x2 rr = *(const u32x2*)(res + off + bj * HALF + n * 16);
                        f32x4 o = acc[ai][bj][m][n]; o[0] += alpha * bflo(rr.x); o[1] += alpha * bfhi(rr.x); o[2] += alpha * bflo(rr.y); o[3] += alpha * bfhi(rr.y);
                        *(f32x4*)(C + off + bj * HALF + n * 16) = o; } }
    }
};
struct EpiSlab {
    static constexpr bool PERM = false;
    float* C; int ldc; size_t slab;
    __device__ __forceinline__ void operator()(const f32x4 (&acc)[2][2][4][2], const Unit& u, int wr, int wc, int fr, int fq) const {
        const int row0 = u.pm * BM + wr * 64 + fr, col0 = u.pn * BM + wc * 32 + 4 * fq; float* base = C + (size_t)u.e * slab;
#pragma unroll
        for (int ai = 0; ai < 2; ++ai)
#pragma unroll
            for (int m = 0; m < 4; ++m) { float* rowp = base + (size_t)(row0 + ai * HALF + m * 16) * ldc + col0;
#pragma unroll
                for (int bj = 0; bj < 2; ++bj)
#pragma unroll
                    for (int n = 0; n < 2; ++n) *(f32x4*)(rowp + bj * HALF + n * 16) = acc[ai][bj][m][n]; }
    }
};
}

struct Params {
    const float *x, *mem, *ln_in_g, *ln_in_b, *w_in, *b_f, *fq_g, *fk_g, *mix_g, *w_out, *ln_mix_g, *ln_mix_b, *mem_ln_g, *mem_ln_b,
                *xa_wq, *xa_wkv, *xa_wo, *ln_xa_g, *ln_xa_b, *router_w, *router_b, *w_up, *b_up, *w_down, *b_down, *ln_moe_g, *ln_moe_b;
    float* out; unsigned char* ws; int ph_lo, ph_hi;
};
#define CAS __attribute__((address_space(4)))
typedef const CAS Params* PP;
#define P_FRESH(pq) asm volatile("" : "+s"(pq))
struct Frame {
    LAS unsigned char* lds; volatile LAS unsigned* MISC; gu32* ctl;
    int tid, lane, wave, vcu, G;
    __device__ __forceinline__ void fresh() { int t = threadIdx.x; asm volatile("" : "+v"(t)); tid = t; lane = t & 63; wave = __builtin_amdgcn_readfirstlane(t >> 6); }
};

__device__ __forceinline__ void tr_item(const float* W, int ldw, int k0, int scol, bf16* WT, int ldk, int drow, LAS float* scr, int lane) {
#pragma unroll 8
    for (int i = 0; i < 32; ++i) { const int kk = 2 * i + (lane >> 5); scr[kk * 33 + (lane & 31)] = W[(size_t)(k0 + kk) * ldw + scol + (lane & 31)]; }
    LDS_WAIT(); asm volatile("" ::: "memory");
    const int c = lane & 7;
#pragma unroll
    for (int j = 0; j < 4; ++j) { const int n = (lane >> 3) + 8 * j; const LAS float* s = scr + (8 * c) * 33 + n;
        u32x4 o; o.x = pk2(s[0 * 33], s[1 * 33]); o.y = pk2(s[2 * 33], s[3 * 33]); o.z = pk2(s[4 * 33], s[5 * 33]); o.w = pk2(s[6 * 33], s[7 * 33]);
        *(GAS u32x4*)(WT + (size_t)(drow + n) * ldk + k0 + 8 * c) = o; }
    LDS_WAIT(); asm volatile("" ::: "memory");
}
constexpr int TR_RS = 192, TR_WAVE_BYTES = 64 * TR_RS;
__device__ __forceinline__ void tr64_load(f32x4 (&v)[16], const float* W, int ldw, int k0, int scol, int lane) {
    const float* src = W + (size_t)(k0 + (lane >> 4)) * ldw + scol + 4 * (lane & 15);
#pragma unroll
    for (int i = 0; i < 16; ++i) v[i] = *(const GAS f32x4*)(src + (size_t)(4 * i) * ldw);
}
__device__ __forceinline__ void tr64_finish(const f32x4 (&v)[16], bf16* WT, int ldk, int k0, int drow, LAS unsigned char* scr, int lane) {
#pragma unroll
    for (int i = 0; i < 16; ++i) { const int k = 4 * i + (lane >> 4); *(LAS u32x2*)(scr + k * TR_RS + 8 * (lane & 15)) = (u32x2){cvt_pk_bf16(v[i][0], v[i][1]), cvt_pk_bf16(v[i][2], v[i][3])}; }
    LDS_WAIT(); asm volatile("" ::: "memory");
    const int G = lane >> 4, i16 = lane & 15, q = i16 >> 2, pp = i16 & 3;
#pragma unroll
    for (int nb = 0; nb < 4; ++nb)
#pragma unroll
        for (int s2 = 0; s2 < 2; ++s2) { const int c = 4 * s2 + G;
            LAS unsigned char* a = scr + (8 * c + q) * TR_RS + (16 * nb + 4 * pp) * 2;
            const s16x4 lo = __builtin_bit_cast(s16x4, __builtin_amdgcn_ds_read_tr16_b64_v4i16((LAS v4i16_t*)a));
            const s16x4 hh = __builtin_bit_cast(s16x4, __builtin_amdgcn_ds_read_tr16_b64_v4i16((LAS v4i16_t*)(a + 4 * TR_RS)));
            const bf16x8 o = {lo[0], lo[1], lo[2], lo[3], hh[0], hh[1], hh[2], hh[3]};
            *(GAS bf16x8*)(WT + (size_t)(drow + 16 * nb + i16) * ldk + k0 + 8 * c) = o; }
    LDS_WAIT(); asm volatile("" ::: "memory");
}
__device__ __forceinline__ void tr64_finish_fp8(const f32x4 (&v)[16], unsigned char* WT, int ldk, int k0, int drow, LAS unsigned char* scr, int lane) {
#pragma unroll
    for (int i = 0; i < 16; ++i) { const int k = 4 * i + (lane >> 4); *(LAS u32x2*)(scr + k * TR_RS + 8 * (lane & 15)) = (u32x2){cvt_pk_bf16(v[i][0], v[i][1]), cvt_pk_bf16(v[i][2], v[i][3])}; }
    LDS_WAIT(); asm volatile("" ::: "memory");
    const int G = lane >> 4, i16 = lane & 15, q = i16 >> 2, pp = i16 & 3;
#pragma unroll
    for (int nb = 0; nb < 4; ++nb) { LAS unsigned char* a = scr + (16 * G + q) * TR_RS + (16 * nb + 4 * pp) * 2; unsigned w[4];
#pragma unroll
        for (int t = 0; t < 4; ++t) { const s16x4 x = __builtin_bit_cast(s16x4, __builtin_amdgcn_ds_read_tr16_b64_v4i16((LAS v4i16_t*)(a + 4 * t * TR_RS)));
            w[t] = pk4_fp8(bf2f((unsigned short)x[0]) * F8S_W, bf2f((unsigned short)x[1]) * F8S_W, bf2f((unsigned short)x[2]) * F8S_W, bf2f((unsigned short)x[3]) * F8S_W); }
        *(GAS u32x4*)(WT + (size_t)(drow + 16 * nb + i16) * ldk + k0 + 16 * G) = (u32x4){w[0], w[1], w[2], w[3]}; }
    LDS_WAIT(); asm volatile("" ::: "memory");
}
__device__ __forceinline__ void ln_row_store(f32x4 (&v)[16], const float* g, const float* b, bf16* orow, float* orow32, int lane, unsigned char* orow8 = nullptr) {
    float s = 0.f;
#pragma unroll
    for (int j = 0; j < 16; ++j) s += (v[j].x + v[j].y) + (v[j].z + v[j].w);
    const float mean = wave_sum(s) * (1.f / DM); float s2 = 0.f;
#pragma unroll
    for (int j = 0; j < 16; ++j) { v[j] = v[j] - mean; s2 += (v[j].x * v[j].x + v[j].y * v[j].y) + (v[j].z * v[j].z + v[j].w * v[j].w); }
    const float rstd = 1.f / sqrtf(wave_sum(s2) * (1.f / DM) + LN_EPS);
    const GAS f32x4* g4 = (const GAS f32x4*)g + lane; const GAS f32x4* b4 = (const GAS f32x4*)b + lane;
#pragma unroll
    for (int j = 0; j < 16; ++j) { const f32x4 gg = g4[64 * j], bb = b4[64 * j]; const f32x4 y = v[j] * rstd * gg + bb;
        if (orow) ((GAS u32x2*)orow)[lane + 64 * j] = (u32x2){pk2(y.x, y.y), pk2(y.z, y.w)};
        if (orow32) ((GAS f32x4*)orow32)[lane + 64 * j] = y;
        if (orow8) ((GAS unsigned*)orow8)[lane + 64 * j] = pk4_fp8(y.x * F8S_H2, y.y * F8S_H2, y.z * F8S_H2, y.w * F8S_H2); }
}
__device__ __forceinline__ void ln_row_f32(const float* xrow, const float* g, const float* b, bf16* orow, int lane) {
    f32x4 v[16];
#pragma unroll
    for (int j = 0; j < 16; ++j) v[j] = ((const GAS f32x4*)xrow)[lane + 64 * j];
    ln_row_store(v, g, b, orow, nullptr, lane);
}

__device__ __forceinline__ void ln_rows_f32(const float* X, const float* g, const float* b, bf16* O, int m0, int stride, int mend, int lane, unsigned char* O8 = nullptr) {
    f32x4 nx[16]; int m = m0;
    if (m < mend) {
#pragma unroll
        for (int j = 0; j < 16; ++j) nx[j] = ((const GAS f32x4*)(X + (size_t)m * DM))[lane + 64 * j]; }
    while (m < mend) {
        f32x4 v[16];
#pragma unroll
        for (int j = 0; j < 16; ++j) v[j] = nx[j];
        const int mc = m; m += stride;
        if (m < mend) {
#pragma unroll
            for (int j = 0; j < 16; ++j) nx[j] = ((const GAS f32x4*)(X + (size_t)m * DM))[lane + 64 * j]; }
        ln_row_store(v, g, b, O + (size_t)mc * DM, nullptr, lane, O8 ? O8 + (size_t)mc * DM : nullptr);
    }
}

constexpr int SHM_KV = 64 * HD * 2;
#define KSWZ(row, colB) ((row) * 256 + ((colB) ^ (((row) & 7) << 4)))
__device__ __forceinline__ int v_st(int k, int c) { const int kk = (k & ~0xC) | ((k & 4) << 1) | ((k & 8) >> 1); return ((kk >> 3) * 4 + (c >> 5)) * 512 + ((kk & 7) * 32 + (c & 31)) * 2; }
__device__ __forceinline__ int v_rd_base(int lane) { return ((lane & 3) << 3) | (((lane >> 2) & 3) << 6) | (((lane >> 4) & 1) << 5) | (((lane >> 5) & 1) << 8); }
constexpr int v_rd_off(int d0, int ks, int half) { return d0 * 512 + ks * 4096 + half * 2048; }
__device__ __forceinline__ int crow(int r, int hi) { return (r & 3) + 8 * (r >> 2) + 4 * hi; }
__device__ __forceinline__ bf16x8 pack8(f32x4 a, f32x4 b) { u32x4 w = {cvt_pk_bf16(a[0], a[1]), cvt_pk_bf16(a[2], a[3]), cvt_pk_bf16(b[0], b[1]), cvt_pk_bf16(b[2], b[3])}; return __builtin_bit_cast(bf16x8, w); }
__device__ __forceinline__ void qkt(f32x16& p0, f32x16& p1, LAS const unsigned char* Kt, int r32, int hi, const bf16x8* qr) {
    p0 = f32x16{}; p1 = f32x16{};
    LAS const unsigned char* kb[4];
#pragma unroll
    for (int dd = 0; dd < 4; ++dd) kb[dd] = Kt + KSWZ(r32, (dd * 16 + hi * 8) * 2);
#pragma unroll
    for (int d0 = 0; d0 < 8; ++d0) { LAS const unsigned char* a = kb[d0 & 3] + (d0 >> 2) * 128;
        const bf16x8 b0 = *(LAS const bf16x8*)a; const bf16x8 b1 = *(LAS const bf16x8*)(a + 32 * 256);
        p0 = __builtin_amdgcn_mfma_f32_32x32x16_bf16(b0, qr[d0], p0, 0, 0, 0);
        p1 = __builtin_amdgcn_mfma_f32_32x32x16_bf16(b1, qr[d0], p1, 0, 0, 0); }
}
__device__ __forceinline__ void pack_p(const f32x16& p0, const f32x16& p1, bf16x8& pa0, bf16x8& pa1, bf16x8& pa2, bf16x8& pa3) {
#define PK4(P, B_, OUT) do { unsigned a0 = cvt_pk_bf16(P[B_+0], P[B_+1]), a1 = cvt_pk_bf16(P[B_+2], P[B_+3]); \
        unsigned b0 = cvt_pk_bf16(P[B_+4], P[B_+5]), b1 = cvt_pk_bf16(P[B_+6], P[B_+7]); \
        auto r0 = __builtin_amdgcn_permlane32_swap(a0, b0, false, false); auto r1 = __builtin_amdgcn_permlane32_swap(a1, b1, false, false); \
        u32x4 w = {r0[0], r1[0], r0[1], r1[1]}; OUT = __builtin_bit_cast(bf16x8, w); } while (0)
    PK4(p0, 0, pa0); PK4(p0, 8, pa1); PK4(p1, 0, pa2); PK4(p1, 8, pa3);
#undef PK4
}
__device__ __forceinline__ void pv_tile(f32x16* o, int vb0, bf16x8 pa0, bf16x8 pa1, bf16x8 pa2, bf16x8 pa3) {
#define TRRD(dst, off) asm volatile("ds_read_b64_tr_b16 %0, %1 offset:%2" : "=&v"(dst) : "v"(vb0), "i"(off) : "memory")
#define PV_D0(d0) do { s16x4 l0, l1, l2, l3, h0, h1, h2, h3; constexpr int b_ = v_rd_off(d0, 0, 0); \
        TRRD(l0, b_); TRRD(h0, b_ + 2048); TRRD(l1, b_ + 4096); TRRD(h1, b_ + 6144); TRRD(l2, b_ + 8192); TRRD(h2, b_ + 10240); TRRD(l3, b_ + 12288); TRRD(h3, b_ + 14336); \
        asm volatile("s_waitcnt lgkmcnt(0)" ::: "memory"); SBAR(); \
        o[d0] = __builtin_amdgcn_mfma_f32_32x32x16_bf16(pa0, (bf16x8){l0[0], l0[1], l0[2], l0[3], h0[0], h0[1], h0[2], h0[3]}, o[d0], 0, 0, 0); \
        o[d0] = __builtin_amdgcn_mfma_f32_32x32x16_bf16(pa1, (bf16x8){l1[0], l1[1], l1[2], l1[3], h1[0], h1[1], h1[2], h1[3]}, o[d0], 0, 0, 0); \
        o[d0] = __builtin_amdgcn_mfma_f32_32x32x16_bf16(pa2, (bf16x8){l2[0], l2[1], l2[2], l2[3], h2[0], h2[1], h2[2], h2[3]}, o[d0], 0, 0, 0); \
        o[d0] = __builtin_amdgcn_mfma_f32_32x32x16_bf16(pa3, (bf16x8){l3[0], l3[1], l3[2], l3[3], h3[0], h3[1], h3[2], h3[3]}, o[d0], 0, 0, 0); } while (0)
    PV_D0(0); PV_D0(1); PV_D0(2); PV_D0(3);
#undef PV_D0
#undef TRRD
}

constexpr int AT_K = 0, AT_V = 2 * SHM_KV, AT_C2 = 4 * SHM_KV, AT_RK = AT_C2 + 8192, AT_WS = AT_RK + 8192, AT_OST = AT_WS + 2048, OST_WAVE = 32 * 33 * 4, AT_END = AT_OST + 8 * OST_WAVE;
static_assert(AT_END <= RING_BYTES, "attention LDS map");

__device__ __forceinline__ void o_rows(const f32x16* o, const float (&il)[16], LAS float* ost, int lane, float (&v)[4][16], float& ss) {
    const int r32 = lane & 31, hi = lane >> 5, row = lane >> 1, half = lane & 1; ss = 0.f;
#pragma unroll
    for (int d0 = 0; d0 < 4; ++d0) {
#pragma unroll
        for (int r = 0; r < 16; ++r) ost[crow(r, hi) * 33 + r32] = o[d0][r] * il[r];
        LDS_WAIT(); asm volatile("" ::: "memory");
#pragma unroll
        for (int i = 0; i < 16; ++i) { v[d0][i] = ost[row * 33 + 16 * half + i]; }
        LDS_WAIT(); asm volatile("" ::: "memory");
#pragma unroll
        for (int i = 0; i < 16; ++i) ss += v[d0][i] * v[d0][i];
    }
}
__device__ __forceinline__ void store16_bf16(bf16* dst, const float (&y)[16]) {
    u32x4 w0 = {cvt_pk_bf16(y[0], y[1]), cvt_pk_bf16(y[2], y[3]), cvt_pk_bf16(y[4], y[5]), cvt_pk_bf16(y[6], y[7])};
    u32x4 w1 = {cvt_pk_bf16(y[8], y[9]), cvt_pk_bf16(y[10], y[11]), cvt_pk_bf16(y[12], y[13]), cvt_pk_bf16(y[14], y[15])};
    *(GAS u32x4*)dst = w0; *(GAS u32x4*)(dst + 8) = w1;
}
__device__ __forceinline__ void fox_tables(Frame F, PP p, int b, int h) {
    F.fresh();
    LAS float* c2t = (LAS float*)(F.lds + AT_C2); LAS float* rkt = (LAS float*)(F.lds + AT_RK); LAS float* red = (LAS float*)(F.lds + AT_WS);
    const float* FL = (const float*)(p->ws + WS_FL); const float bfh = p->b_f[h];
    __syncthreads();
    float v[4], run = 0.f;
#pragma unroll
    for (int i = 0; i < 4; ++i) { const float x = FL[(size_t)(b * SEQ + 4 * F.tid + i) * 16 + h] + bfh; const float y = -x * LOG2E;
        const float sp = fmaxf(y, 0.f) + __builtin_amdgcn_logf(1.f + __builtin_amdgcn_exp2f(-fabsf(y))); run -= sp; v[i] = run; }
    float incl = run;
#pragma unroll
    for (int o = 1; o < 64; o <<= 1) { const float t = __shfl_up(incl, o); if (F.lane >= o) incl += t; }
    if (F.lane == 63) red[F.wave] = incl;
    __syncthreads();
    float woff = 0.f;
    for (int w = 0; w < F.wave; ++w) woff += red[w];
    const float base = woff + incl - run;
#pragma unroll
    for (int i = 0; i < 4; ++i) c2t[4 * F.tid + i] = v[i] + base;
    const bf16* Kg = (const bf16*)(p->ws + WS_P) + (size_t)(b * SEQ) * NP + PC_KF + h * HD + (F.lane & 15) * 8;
#pragma unroll 8
    for (int it = 0; it < 64; ++it) { const int s = F.wave * 256 + it * 4 + (F.lane >> 4);
        const u32x4 w = *(const GAS u32x4*)(Kg + (size_t)s * NP);
        float ss = bflo(w.x) * bflo(w.x) + bfhi(w.x) * bfhi(w.x) + bflo(w.y) * bflo(w.y) + bfhi(w.y) * bfhi(w.y) + bflo(w.z) * bflo(w.z) + bfhi(w.z) * bfhi(w.z) + bflo(w.w) * bflo(w.w) + bfhi(w.w) * bfhi(w.w);
        ss += __shfl_xor(ss, 1); ss += __shfl_xor(ss, 2); ss += __shfl_xor(ss, 4); ss += __shfl_xor(ss, 8);
        if ((F.lane & 15) == 0) rkt[s] = 1.f / sqrtf(ss * (1.f / HD) + RMS_EPS); }
    __syncthreads();
}

template <int MODE>
__device__ __forceinline__ void attn_unit(Frame F, PP p, int b, int h, int qb) {
    F.fresh();
    const int lane = F.lane, wave = F.wave, r32 = lane & 31, hi = lane >> 5;
    const bf16* Pg = (const bf16*)(p->ws + WS_P) + (size_t)(b * SEQ) * NP;
    const int cq = (MODE == 0 ? PC_QF : PC_QS) + h * HD, ck = (MODE == 0 ? PC_KF : PC_KS) + h * HD, cv = (MODE == 0 ? PC_VF : PC_VS) + h * HD;
    LAS const float* c2t = (LAS const float*)(F.lds + AT_C2); LAS const float* rkt = (LAS const float*)(F.lds + AT_RK);
    const int trow = 256 * qb + 32 * wave;
    const int jd = 4 * qb + (wave >> 1), lam = 32 * (wave & 1) + r32, NT = 4 * qb + 4;
    unsigned dk[2], dv[2];
#pragma unroll
    for (int i = 0; i < 2; ++i) { const int q = (wave * 2 + i) * 1024 + lane * 16;
        { const int row = q >> 8, cb = (q & 255) ^ ((row & 7) << 4); dk[i] = (unsigned)(row * NP + ck + (cb >> 1)); }
        { const int st = q >> 9, inner = (q & 511) >> 1, kk = (st >> 2) * 8 + (inner >> 5), c = (st & 3) * 32 + (inner & 31); const int k = (kk & ~0xC) | ((kk & 4) << 1) | ((kk & 8) >> 1);
          dv[i] = (unsigned)(k * NP + cv + c); } }
#define AT_DMA(j, bf) do { const bf16* tb_ = Pg + (size_t)(64 * (j)) * NP; LAS unsigned char* kd_ = F.lds + AT_K + (bf) * SHM_KV + wave * 2048; LAS unsigned char* vd_ = F.lds + AT_V + (bf) * SHM_KV + wave * 2048; \
        __builtin_amdgcn_global_load_lds((const unsigned*)(tb_ + dk[0]), (LAS unsigned*)kd_, 16, 0, 0); __builtin_amdgcn_global_load_lds((const unsigned*)(tb_ + dk[1]), (LAS unsigned*)(kd_ + 1024), 16, 0, 0); \
        __builtin_amdgcn_global_load_lds((const unsigned*)(tb_ + dv[0]), (LAS unsigned*)vd_, 16, 0, 0); __builtin_amdgcn_global_load_lds((const unsigned*)(tb_ + dv[1]), (LAS unsigned*)(vd_ + 1024), 16, 0, 0); } while (0)
    __syncthreads();
    AT_DMA(MODE == 0 ? 0 : NT - 1, 0);
    bf16x8 qr[8];
    { const bf16* qp = Pg + (size_t)(trow + r32) * NP + cq + hi * 8;
      u32x4 raw[8];
#pragma unroll
      for (int d0 = 0; d0 < 8; ++d0) raw[d0] = *(const GAS u32x4*)(qp + 16 * d0);
      float sc_q = C2;
      if (MODE == 0) { float ss = 0.f;
#pragma unroll
          for (int d0 = 0; d0 < 8; ++d0) { const u32x4 w = raw[d0]; ss += bflo(w.x) * bflo(w.x) + bfhi(w.x) * bfhi(w.x) + bflo(w.y) * bflo(w.y) + bfhi(w.y) * bfhi(w.y) + bflo(w.z) * bflo(w.z) + bfhi(w.z) * bfhi(w.z) + bflo(w.w) * bflo(w.w) + bfhi(w.w) * bfhi(w.w); }
          ss += __shfl_xor(ss, 32); sc_q = C2 / sqrtf(ss * (1.f / HD) + RMS_EPS); }
#pragma unroll
      for (int d0 = 0; d0 < 8; ++d0) { const u32x4 w = raw[d0]; f32x4 a = {bflo(w.x), bfhi(w.x), bflo(w.y), bfhi(w.y)}, c = {bflo(w.z), bfhi(w.z), bflo(w.w), bfhi(w.w)};
          if (MODE == 0) { const GAS f32x4* gq = (const GAS f32x4*)(p->fq_g + 16 * d0 + 8 * hi); const GAS f32x4* gk = (const GAS f32x4*)(p->fk_g + 16 * d0 + 8 * hi);
              a = a * (gq[0] * gk[0]); c = c * (gq[1] * gk[1]); asm volatile("" ::: "memory"); }
          qr[d0] = pack8(a * sc_q, c * sc_q); } }
    f32x16 o[4] = {};
    float lsum = 0.f;
    const float ref = (MODE == 0) ? c2t[trow + 31] : 0.f;
    bf16x8 Atri0, Atri1, Aone; f32x16 carry = {};
    if (MODE == 1) {
#pragma unroll
        for (int j = 0; j < 8; ++j) { const int k0 = 8 * (j >> 2) + 4 * hi + (j & 3); Atri0[j] = (k0 > r32) ? (short)0xBF80 : (short)0; Atri1[j] = (16 + k0 > r32) ? (short)0xBF80 : (short)0; Aone[j] = (short)0xBF80; }
    }
    const int koff = KSWZ(r32, hi * 16), vroff = v_rd_base(lane);
    for (int it = 0; it < NT; ++it) {
        const int j = (MODE == 0) ? it : NT - 1 - it; const int bf = it & 1;
        asm volatile("s_waitcnt vmcnt(0)" ::: "memory");
        __syncthreads();
        if (it + 1 < NT) AT_DMA(MODE == 0 ? it + 1 : NT - 2 - it, bf ^ 1);
        if (j <= jd) {
            LAS const unsigned char* Kt = F.lds + AT_K + bf * SHM_KV; const int vb0 = (int)(uintptr_t)(F.lds + AT_V + bf * SHM_KV) + vroff;
            f32x16 p0 = {}, p1 = {};
#pragma unroll
            for (int d0 = 0; d0 < 8; ++d0) { LAS const unsigned char* a = Kt + (koff ^ ((d0 & 3) << 5)) + (d0 >> 2) * 128;
                const bf16x8 b0 = *(LAS const bf16x8*)a; const bf16x8 b1 = *(LAS const bf16x8*)(a + 32 * 256);
                p0 = __builtin_amdgcn_mfma_f32_32x32x16_bf16(b0, qr[d0], p0, 0, 0, 0);
                p1 = __builtin_amdgcn_mfma_f32_32x32x16_bf16(b1, qr[d0], p1, 0, 0, 0); }
            if (MODE == 0) {
#pragma unroll
                for (int g = 0; g < 4; ++g) { const f32x4 rk0 = *(LAS const f32x4*)(rkt + 64 * j + 8 * g + 4 * hi), rk1 = *(LAS const f32x4*)(rkt + 64 * j + 32 + 8 * g + 4 * hi);
                    const f32x4 cc0 = *(LAS const f32x4*)(c2t + 64 * j + 8 * g + 4 * hi), cc1 = *(LAS const f32x4*)(c2t + 64 * j + 32 + 8 * g + 4 * hi);
#pragma unroll
                    for (int i = 0; i < 4; ++i) { p0[4 * g + i] = fmaf(p0[4 * g + i], rk0[i], ref - cc0[i]); p1[4 * g + i] = fmaf(p1[4 * g + i], rk1[i], ref - cc1[i]); }
                    if (g & 1) asm volatile("" ::: "memory"); }
                if (j == jd) { int lam2 = lam - 4 * hi; asm volatile("" : "+v"(lam2));
#pragma unroll
                    for (int r = 0; r < 16; ++r) { const int kap = (r & 3) + 8 * (r >> 2); if (kap > lam2) p0[r] = -__builtin_inff(); if (kap + 32 > lam2) p1[r] = -__builtin_inff(); } }
#pragma unroll
                for (int r = 0; r < 16; ++r) { p0[r] = __builtin_amdgcn_exp2f(p0[r]); p1[r] = __builtin_amdgcn_exp2f(p1[r]); lsum += p0[r] + p1[r]; }
            } else {
                f32x16 s0, s1;
#pragma unroll
                for (int r = 0; r < 16; ++r) { s0[r] = __builtin_amdgcn_logf(1.f + __builtin_amdgcn_exp2f(p0[r])); s1[r] = __builtin_amdgcn_logf(1.f + __builtin_amdgcn_exp2f(p1[r])); }
                if (j == jd) { int lam2 = lam - 4 * hi; asm volatile("" : "+v"(lam2));
#pragma unroll
                    for (int r = 0; r < 16; ++r) { const int kap = (r & 3) + 8 * (r >> 2); if (kap >= lam2) s0[r] = 0.f; if (kap + 32 >= lam2) s1[r] = 0.f; } }
#pragma unroll
                for (int r = 0; r < 16; ++r) { p0[r] -= s0[r]; p1[r] -= s1[r]; }
                const float s00 = s0[0];
                const bf16x8 bs0 = pack8((f32x4){s0[0], s0[1], s0[2], s0[3]}, (f32x4){s0[4], s0[5], s0[6], s0[7]}), bs1 = pack8((f32x4){s0[8], s0[9], s0[10], s0[11]}, (f32x4){s0[12], s0[13], s0[14], s0[15]});
                const bf16x8 bs2 = pack8((f32x4){s1[0], s1[1], s1[2], s1[3]}, (f32x4){s1[4], s1[5], s1[6], s1[7]}), bs3 = pack8((f32x4){s1[8], s1[9], s1[10], s1[11]}, (f32x4){s1[12], s1[13], s1[14], s1[15]});
                f32x16 t0 = __builtin_amdgcn_mfma_f32_32x32x16_bf16(Atri0, bs0, carry, 0, 0, 0);
                f32x16 t1 = __builtin_amdgcn_mfma_f32_32x32x16_bf16(Atri0, bs2, carry, 0, 0, 0);
                t0 = __builtin_amdgcn_mfma_f32_32x32x16_bf16(Atri1, bs1, t0, 0, 0, 0);
                t1 = __builtin_amdgcn_mfma_f32_32x32x16_bf16(Atri1, bs3, t1, 0, 0, 0);
                t0 = __builtin_amdgcn_mfma_f32_32x32x16_bf16(Aone, bs2, t0, 0, 0, 0);
                t0 = __builtin_amdgcn_mfma_f32_32x32x16_bf16(Aone, bs3, t0, 0, 0, 0);
                { const float cv_ = t0[0] - s00; auto rr = __builtin_amdgcn_permlane32_swap(__float_as_uint(cv_), __float_as_uint(cv_), false, false); const float cn = __uint_as_float(rr[0]);
#pragma unroll
                  for (int r = 0; r < 16; ++r) carry[r] = cn; }
#pragma unroll
                for (int r = 0; r < 16; ++r) { p0[r] = __builtin_amdgcn_exp2f(p0[r] + t0[r]); p1[r] = __builtin_amdgcn_exp2f(p1[r] + t1[r]); }
                if (j == jd) { int lam2 = lam - 4 * hi; asm volatile("" : "+v"(lam2));
#pragma unroll
                    for (int r = 0; r < 16; ++r) { const int kap = (r & 3) + 8 * (r >> 2); if (kap >= lam2) p0[r] = 0.f; if (kap + 32 >= lam2) p1[r] = 0.f; } }
            }
            bf16x8 pa0, pa1, pa2, pa3;
            pack_p(p0, p1, pa0, pa1, pa2, pa3);
            pv_tile(o, vb0, pa0, pa1, pa2, pa3);
        }
    }
#undef AT_DMA
    int b2 = b, h2 = h, qb2 = qb;
    asm volatile("" : "+s"(b2), "+s"(h2), "+s"(qb2));
    P_FRESH(p);
    LAS float* wsw = (LAS float*)(F.lds + AT_WS) + 64 + wave * 48; LAS float* ost = (LAS float*)(F.lds + AT_OST + wave * OST_WAVE);
    float il[16];
    if (MODE == 0) { lsum += __shfl_xor(lsum, 32); if (hi == 0) wsw[r32] = 1.f / lsum; LDS_WAIT(); asm volatile("" ::: "memory");
#pragma unroll
        for (int r = 0; r < 16; ++r) il[r] = wsw[crow(r, hi)]; }
    else {
#pragma unroll
        for (int r = 0; r < 16; ++r) il[r] = 1.f; }
    float v[4][16], ss;
    o_rows(o, il, ost, lane, v, ss);
    ss += __shfl_xor(ss, 1);
    const float rstd = 1.f / sqrtf(ss * (1.f / HD) + RMS_EPS);
    const int row = lane >> 1, half = lane & 1; const size_t srow = (size_t)b2 * SEQ + 256 * qb2 + 32 * wave + row;
    const float* mg = p->mix_g + (MODE == 0 ? h2 : NFH + h2) * HD + 16 * half;
    bf16* Og = (bf16*)(p->ws + WS_O) + srow * DM + (MODE == 0 ? 0 : NFH * HD) + h2 * HD + 16 * half;
    const bf16* Gg = (const bf16*)(p->ws + WS_P) + srow * NP + PC_GF + h2 * HD + 16 * half;
#pragma unroll
    for (int d0 = 0; d0 < 4; ++d0) { float y[16];
#pragma unroll
        for (int q4 = 0; q4 < 4; ++q4) { const f32x4 g4 = *(const GAS f32x4*)(mg + 32 * d0 + 4 * q4);
#pragma unroll
            for (int i = 0; i < 4; ++i) y[4 * q4 + i] = v[d0][4 * q4 + i] * rstd * g4[i]; }
        if (MODE == 0) { const u32x4 ga = *(const GAS u32x4*)(Gg + 32 * d0), gb = *(const GAS u32x4*)(Gg + 32 * d0 + 8);
            const unsigned gw[8] = {ga.x, ga.y, ga.z, ga.w, gb.x, gb.y, gb.z, gb.w};
#pragma unroll
            for (int i = 0; i < 8; ++i) { y[2 * i] *= 1.f / (1.f + __builtin_amdgcn_exp2f(-LOG2E * bflo(gw[i]))); y[2 * i + 1] *= 1.f / (1.f + __builtin_amdgcn_exp2f(-LOG2E * bfhi(gw[i]))); } }
        store16_bf16(Og + 32 * d0, y); asm volatile("" ::: "memory"); }
}

__device__ __forceinline__ void xattn_unit(Frame F, PP p, int b, int xh, int qblk) {
    F.fresh();
    const int lane = F.lane, wave = F.wave, tid = F.tid, r32 = lane & 31, hi = lane >> 5;
    const float* QS = (const float*)(p->ws + WS_QS);
    LAS unsigned char* Kt = F.lds; LAS unsigned char* Vt = F.lds + 65536;
    const int sr = tid >> 4, sc = (tid & 15) * 8, vst0 = v_st(sr, sc), vst1 = v_st(32 + sr, sc), kws = KSWZ(sr, sc * 2);
    __syncthreads();
    { const bf16* KVB = (const bf16*)(p->ws + WS_KVB); u32x4 kk[4][2], vv[4][2];
#pragma unroll
      for (int t = 0; t < 4; ++t)
#pragma unroll
          for (int rr = 0; rr < 2; ++rr) { const bf16* base = KVB + (size_t)(b * NMEM + 64 * t + sr + 32 * rr) * (2 * XW) + xh * HD + sc;
              kk[t][rr] = *(const GAS u32x4*)base; vv[t][rr] = *(const GAS u32x4*)(base + XW); }
#pragma unroll
      for (int t = 0; t < 4; ++t)
#pragma unroll
          for (int rr = 0; rr < 2; ++rr) { *(LAS u32x4*)(Kt + t * SHM_KV + kws + rr * 32 * 256) = kk[t][rr]; *(LAS u32x4*)(Vt + t * SHM_KV + (rr ? vst1 : vst0)) = vv[t][rr]; } }
    __syncthreads();
    f32x16 o[4] = {}; float lsum = 0.f, m = -1e30f;
    const size_t tok0 = (size_t)b * SEQ + 128 * qblk + 32 * (wave & 3);
    if (wave < 4) {
        bf16x8 qr[8];
#pragma unroll
        for (int d0 = 0; d0 < 8; ++d0) { f32x4 a = {0.f, 0.f, 0.f, 0.f}, c = a;
#pragma unroll
            for (int s = 0; s < QSPLIT; ++s) { const float* qp = QS + ((size_t)s * NTOK + tok0 + r32) * XW + xh * HD + 16 * d0 + 8 * hi; a += *(const GAS f32x4*)qp; c += *(const GAS f32x4*)(qp + 4); }
            qr[d0] = pack8(a * C2, c * C2); }
#pragma unroll 1
        for (int t = 0; t < 4; ++t) { f32x16 p0, p1; qkt(p0, p1, Kt + t * SHM_KV, r32, hi, qr);
#pragma unroll
            for (int r = 0; r < 16; ++r) m = fmaxf(m, fmaxf(p0[r], p1[r])); }
        { auto rr = __builtin_amdgcn_permlane32_swap(__float_as_uint(m), __float_as_uint(m), false, false); m = fmaxf(__uint_as_float(rr[0]), __uint_as_float(rr[1])); }
#pragma unroll 1
        for (int t = 0; t < 4; ++t) { f32x16 p0, p1; qkt(p0, p1, Kt + t * SHM_KV, r32, hi, qr);
#pragma unroll
            for (int r = 0; r < 16; ++r) { p0[r] = __builtin_amdgcn_exp2f(p0[r] - m); p1[r] = __builtin_amdgcn_exp2f(p1[r] - m); lsum += p0[r] + p1[r]; }
            bf16x8 pa0, pa1, pa2, pa3; pack_p(p0, p1, pa0, pa1, pa2, pa3);
            pv_tile(o, (int)(uintptr_t)(Vt + t * SHM_KV) + v_rd_base(lane), pa0, pa1, pa2, pa3); }
        lsum += __shfl_xor(lsum, 32);
    }
    __syncthreads();
    if (wave < 4) {
        LAS float* wsw = (LAS float*)(F.lds + 32768) + wave * 64; LAS float* ost = (LAS float*)(F.lds + wave * OST_WAVE);
        if (hi == 0) wsw[r32] = 1.f / lsum; LDS_WAIT(); asm volatile("" ::: "memory");
        float il[16];
#pragma unroll
        for (int r = 0; r < 16; ++r) il[r] = wsw[crow(r, hi)];
        float v[4][16], ss; o_rows(o, il, ost, lane, v, ss);
        const int row = lane >> 1, half = lane & 1;
        bf16* Og = (bf16*)(p->ws + WS_OX) + (tok0 + row) * XW + xh * HD + 16 * half;
#pragma unroll
        for (int d0 = 0; d0 < 4; ++d0) store16_bf16(Og + 32 * d0, v[d0]);
    }
}

__device__ __forceinline__ void flogit_rows(Frame F, PP p, int row0  ) {
    F.fresh();
    typedef float f32x4v __attribute__((ext_vector_type(4)));
    const bf16* H0 = (const bf16*)(p->ws + WS_H0); const bf16* WfT = (const bf16*)(p->ws + WS_WF);
    const int rt = F.wave >> 2, kq = F.wave & 3, l15 = F.lane & 15, lq = F.lane >> 4;
    const bf16* ap = H0 + (size_t)(row0 + 16 * rt + l15) * DM + kq * 1024 + 8 * lq;
    const bf16* bp = WfT + (size_t)l15 * DM + kq * 1024 + 8 * lq;
    f32x4v acc = {0.f, 0.f, 0.f, 0.f};
#pragma unroll 8
    for (int ks = 0; ks < 32; ++ks) { const bf16x8 a = *(const GAS bf16x8*)(ap + 32 * ks), bb = *(const GAS bf16x8*)(bp + 32 * ks);
        acc = __builtin_amdgcn_mfma_f32_16x16x32_bf16(a, bb, acc, 0, 0, 0); }
    LAS float* red = (LAS float*)F.lds;
    __syncthreads();
#pragma unroll
    for (int i = 0; i < 4; ++i) red[F.wave * 256 + (4 * lq + i) * 16 + l15] = acc[i];
    __syncthreads();
    { const int t = F.tid, rt2 = t >> 8, rc = t & 255; const LAS float* q = red + rt2 * 1024 + rc;
      ((float*)(p->ws + WS_FL))[(size_t)(row0 + 16 * rt2 + (rc >> 4)) * 16 + (rc & 15)] = (q[0] + q[256]) + (q[512] + q[768]); }
}

__device__ __forceinline__ void router_rows(Frame F, PP p, int row0  ) {
    F.fresh();
    typedef float f32x4v __attribute__((ext_vector_type(4)));
    const bf16* H2 = (const bf16*)(p->ws + WS_H2); const bf16* WrT = (const bf16*)(p->ws + WS_WR);
    const int rt = F.wave >> 2, kq = F.wave & 3, l15 = F.lane & 15, lq = F.lane >> 4;
    const bf16* ap = H2 + (size_t)(row0 + 16 * rt + l15) * DM + kq * 1024 + 8 * lq;
    const bf16* bp0 = WrT + (size_t)l15 * DM + kq * 1024 + 8 * lq; const bf16* bp1 = bp0 + (size_t)16 * DM;
    f32x4v acc0 = {0.f, 0.f, 0.f, 0.f}, acc1 = acc0;
#pragma unroll 8
    for (int ks = 0; ks < 32; ++ks) { const bf16x8 a = *(const GAS bf16x8*)(ap + 32 * ks), b0 = *(const GAS bf16x8*)(bp0 + 32 * ks), b1 = *(const GAS bf16x8*)(bp1 + 32 * ks);
        acc0 = __builtin_amdgcn_mfma_f32_16x16x32_bf16(a, b0, acc0, 0, 0, 0); acc1 = __builtin_amdgcn_mfma_f32_16x16x32_bf16(a, b1, acc1, 0, 0, 0); }
    LAS float* red = (LAS float*)F.lds;
    __syncthreads();
#pragma unroll
    for (int i = 0; i < 4; ++i) { red[F.wave * 512 + (4 * lq + i) * 32 + l15] = acc0[i]; red[F.wave * 512 + (4 * lq + i) * 32 + 16 + l15] = acc1[i]; }
    __syncthreads();
    LAS float* lg = red + 4096;
    for (int t = F.tid; t < 1024; t += 512) { const int r = t >> 5, e = t & 31, rt2 = r >> 4; const LAS float* q = red + rt2 * 2048 + (r & 15) * 32 + e;
        lg[r * 33 + e] = (q[0] + q[512]) + (q[1024] + q[1536]) + p->router_b[e]; }
    __syncthreads();
    if (F.tid < 32) { const int r = F.tid; float val[4]; int idx[4]; unsigned used = 0u;
#pragma unroll
        for (int k = 0; k < 4; ++k) { float best = -__builtin_inff(); int bi = 0;
            for (int e = 0; e < 32; ++e) { const float x = lg[r * 33 + e]; if (!((used >> e) & 1u) && x > best) { best = x; bi = e; } }
            val[k] = best; idx[k] = bi; used |= 1u << bi; }
        float w[4], s = 0.f;
#pragma unroll
        for (int k = 0; k < 4; ++k) { w[k] = __builtin_amdgcn_exp2f((val[k] - val[0]) * LOG2E); s += w[k]; }
        const float inv = 1.f / s; const int tok = row0 + r;
        int* LIST = (int*)(p->ws + WS_LIST); float* GATE = (float*)(p->ws + WS_GATE); unsigned* cnt = (unsigned*)(p->ws + WS_CTL) + CW_CNT;
#pragma unroll
        for (int k = 0; k < 4; ++k) { const unsigned pos = atomicAdd(cnt + 64 * idx[k], 1u); LIST[idx[k] * NTOK + pos] = tok * 4 + k; GATE[tok * 4 + k] = w[k] * inv; } }
}

namespace pg8 {
struct MoeSched {
    const char* A; const char* Bt; size_t bstride_e; int lda, ldb, NT, G, c; LAS const int* tab; bool gather;
    __device__ __forceinline__ bool next(int i, Unit& u) const {
        const int TM = __builtin_amdgcn_readfirstlane(tab[64]); const int nwg = NT * TM; const long L = (long)i * G + c; if (L >= nwg) return false;
        const int wgid = xcd_remap((int)L, nwg); const int mtg = wgid / NT; u.pn = wgid - mtg * NT;
        int e = 0;
        for (int k = 1; k < NE; ++k) e += (__builtin_amdgcn_readfirstlane(tab[32 + k]) <= mtg) ? 1 : 0;
        u.e = e; u.pm = mtg - __builtin_amdgcn_readfirstlane(tab[32 + e]); u.aux = i; return true;
    }
    __device__ __forceinline__ int a_off(const Unit& u) const { return gather ? 0 : (BM * (__builtin_amdgcn_readfirstlane(tab[32 + u.e]) + u.pm)) * lda; }
    __device__ __forceinline__ int b_off(const Unit& u) const { return u.e * (int)bstride_e + u.pn * BM * ldb; }
    __device__ __forceinline__ int arow(const Unit& u, int pos) const { return gather ? tab[128 + 256 * u.aux + pos] : pos; }
};
struct EpiUp {
    static constexpr bool PERM = true;
    unsigned char* ACT; const float* b_up; LAS const int* tab;
    __device__ __forceinline__ void operator()(const f32x4 (&acc)[2][2][4][2], const Unit& u, int wr, int wc, int fr, int fq) const {
        const int seg = BM * tab[32 + u.e]; const int row0 = seg + u.pm * BM + wr * 64 + fr, jcol = 128 * u.pn + 32 * wc + 8 * fq;
        const float* bg = b_up + (size_t)u.e * (2 * DE) + jcol; const float* bu = bg + DE;
        const f32x4 bg0 = *(const GAS f32x4*)bg, bg1 = *(const GAS f32x4*)(bg + 4), bu0 = *(const GAS f32x4*)bu, bu1 = *(const GAS f32x4*)(bu + 4);
#pragma unroll
        for (int ai = 0; ai < 2; ++ai)
#pragma unroll
            for (int m = 0; m < 4; ++m) { unsigned char* rowp = ACT + (size_t)(row0 + ai * HALF + m * 16) * DE + jcol; float a[8];
#pragma unroll
                for (int n = 0; n < 2; ++n) { const f32x4 gv = acc[ai][0][m][n] + (n ? bg1 : bg0), uv = acc[ai][1][m][n] + (n ? bu1 : bu0);
#pragma unroll
                    for (int i = 0; i < 4; ++i) { const float g = fminf(gv[i], 7.f), uu = fminf(fmaxf(uv[i], -7.f), 7.f);
                        a[4 * n + i] = (uu + 1.f) * g / (1.f + __builtin_amdgcn_exp2f(-1.702f * LOG2E * g)); } }
                *(u32x2*)rowp = (u32x2){pk4_fp8(a[0] * F8S_ACT, a[1] * F8S_ACT, a[2] * F8S_ACT, a[3] * F8S_ACT), pk4_fp8(a[4] * F8S_ACT, a[5] * F8S_ACT, a[6] * F8S_ACT, a[7] * F8S_ACT)}; }
    }
};
struct EpiDown {
    static constexpr bool PERM = true;
    bf16* Y; const float* b_down; const int* LIST; const float* GATE; LAS const int* tab;
    __device__ __forceinline__ void operator()(const f32x4 (&acc)[2][2][4][2], const Unit& u, int wr, int wc, int fr, int fq) const {
        const int cnt = tab[u.e]; const int col0 = u.pn * BM + wc * 32 + 8 * fq; const float* bd = b_down + (size_t)u.e * DM + col0;
        f32x4 bv[2][2];
#pragma unroll
        for (int bj = 0; bj < 2; ++bj)
#pragma unroll
            for (int n = 0; n < 2; ++n) bv[bj][n] = *(const GAS f32x4*)(bd + bj * HALF + 4 * n);
#pragma unroll
        for (int ai = 0; ai < 2; ++ai)
#pragma unroll
            for (int m = 0; m < 4; ++m) { const int pos = u.pm * BM + ai * HALF + wr * 64 + m * 16 + fr;
                if (pos < cnt) { const int lv = LIST[(size_t)u.e * NTOK + pos]; const float gt = GATE[lv]; bf16* rowp = Y + (size_t)lv * DM + col0;
#pragma unroll
                    for (int bj = 0; bj < 2; ++bj) { const f32x4 v0 = (acc[ai][bj][m][0] + bv[bj][0]) * gt, v1 = (acc[ai][bj][m][1] + bv[bj][1]) * gt;
                        u32x4 w = {cvt_pk_bf16(v0[0], v0[1]), cvt_pk_bf16(v0[2], v0[3]), cvt_pk_bf16(v1[0], v1[1]), cvt_pk_bf16(v1[2], v1[3])};
                        *(u32x4*)(rowp + bj * HALF) = w; } } }
    }
};
}
__device__ __forceinline__ void moe_tables(Frame F, PP p, int NT, bool gather) {
    F.fresh();
    LAS int* tab = (LAS int*)(F.lds + LDSX_OFF); const unsigned* cnt = (const unsigned*)(p->ws + WS_CTL) + CW_CNT;
    __syncthreads();
    if (F.tid < NE) { unsigned c = __hip_atomic_load(cnt + 64 * F.tid, RLX_AGENT); tab[F.tid] = (int)(c > (unsigned)NTOK ? (unsigned)NTOK : c); }
    __syncthreads();
    if (F.tid == 0) { int s = 0; for (int e = 0; e < NE; ++e) { tab[32 + e] = s; s += (tab[e] + 255) >> 8; } tab[64] = s; }
    __syncthreads();
    if (gather) {
        const int TM = tab[64], nwg = NT * TM; const int* LIST = (const int*)(p->ws + WS_LIST);
        for (int i = 0; i < 10; ++i) { const long L = (long)i * F.G + (int)blockIdx.x; if (L >= nwg) break;
            const int wgid = pg8::xcd_remap((int)L, nwg), mtg = wgid / NT; int e = 0; for (int k = 1; k < NE; ++k) e += (tab[32 + k] <= mtg) ? 1 : 0;
            const int pm = mtg - tab[32 + e];
            if (F.tid < 256) { const int pos = pm * 256 + F.tid; tab[128 + 256 * i + F.tid] = (pos < tab[e]) ? (LIST[(size_t)e * NTOK + pos] >> 2) : 0; } }
        __syncthreads();
    }
}

constexpr int I_A = 64 * 128, I_B = 64 * 96, I_C = 64 * 64, I_D = 64 * 8, I_E = 64 * 16, I_F = 8 * 64, I_H = 32 * 64 * 32, I_I = 32 * 16 * 64;
constexpr int NITEMS = I_A + I_B + I_C + I_D + I_E + I_F + I_H + I_I, NITEMS_DENSE = NITEMS - I_H - I_I;
struct TrItem { const float* W; bf16* WT; int ldw, k0, scol, ldk, drow, f8; };
__device__ __forceinline__ void tr_decode(int r, PP p, TrItem& t) {
    unsigned char* ws = p->ws; t.f8 = 0;
    if (r < I_A) { const int kb = r / 128, nb = r % 128; t.W = p->w_in; t.ldw = N_IN_SRC; t.k0 = 64 * kb; t.scol = 64 * nb; t.WT = (bf16*)(ws + WS_WIN); t.ldk = DM; t.drow = 64 * nb; return; } r -= I_A;
    if (r < I_B) { const int kb = r / 96, nb = r % 96; t.W = p->w_in; t.ldw = N_IN_SRC; t.k0 = 64 * kb; t.scol = 8208 + 64 * nb; t.WT = (bf16*)(ws + WS_WIN); t.ldk = DM; t.drow = 8192 + 64 * nb; return; } r -= I_B;
    if (r < I_C) { const int kb = r / 64, nb = r % 64; t.W = p->w_out; t.ldw = DM; t.k0 = 64 * kb; t.scol = 64 * nb; t.WT = (bf16*)(ws + WS_WOUT); t.ldk = DM; t.drow = 64 * nb; return; } r -= I_C;
    if (r < I_D) { const int kb = r / 8, nb = r % 8; t.W = p->xa_wq; t.ldw = XW; t.k0 = 64 * kb; t.scol = 64 * nb; t.WT = (bf16*)(ws + WS_WQ); t.ldk = DM; t.drow = 64 * nb; return; } r -= I_D;
    if (r < I_E) { const int kb = r / 16, nb = r % 16; t.W = p->xa_wkv; t.ldw = 2 * XW; t.k0 = 64 * kb; t.scol = 64 * nb; t.WT = (bf16*)(ws + WS_WKV); t.ldk = DM; t.drow = 64 * nb; return; } r -= I_E;
    if (r < I_F) { const int kb = r / 64, nb = r % 64; t.W = p->xa_wo; t.ldw = DM; t.k0 = 64 * kb; t.scol = 64 * nb; t.WT = (bf16*)(ws + WS_WO); t.ldk = XW; t.drow = 64 * nb; return; } r -= I_F;
    if (r < I_H) { const int e = r / 2048, q = r % 2048, kb = q / 32, nb = q % 32, tt = nb >> 2, bj = (nb >> 1) & 1, qq = nb & 1;
        t.W = p->w_up + (size_t)e * DM * (2 * DE); t.ldw = 2 * DE; t.k0 = 64 * kb; t.scol = (bj ? DE : 0) + 128 * tt + 64 * qq; t.WT = (bf16*)(ws + WS_WUP + (size_t)e * (2 * DE) * DM); t.ldk = DM; t.drow = 64 * nb; t.f8 = 1; return; } r -= I_H;
    { const int e = r / 1024, q = r % 1024, kb = q / 64, nb = q % 64; t.W = p->w_down + (size_t)e * DE * DM; t.ldw = DM; t.k0 = 64 * kb; t.scol = 64 * nb; t.WT = (bf16*)(ws + WS_WDN + (size_t)e * DM * DE); t.ldk = DE; t.drow = 64 * nb; t.f8 = 1; }
}
__device__ __forceinline__ void tr_run(PP p, int it0, int it1, int wslot, int stride, LAS unsigned char* scr, int lane) {
    f32x4 v[16]; TrItem t; int it = it0 + wslot;
    if (it < it1) { tr_decode(it, p, t); tr64_load(v, t.W, t.ldw, t.k0, t.scol, lane); }
    while (it < it1) {
        f32x4 c[16];
#pragma unroll
        for (int i = 0; i < 16; ++i) c[i] = v[i];
        const TrItem tc = t;
        it += stride;
        if (it < it1) { tr_decode(it, p, t); tr64_load(v, t.W, t.ldw, t.k0, t.scol, lane); }
        if (tc.f8) tr64_finish_fp8(c, (unsigned char*)tc.WT, tc.ldk, tc.k0, tc.drow, scr, lane); else tr64_finish(c, tc.WT, tc.ldk, tc.k0, tc.drow, scr, lane);
    }
}

constexpr int N_PHASES = 12;
__global__ void __launch_bounds__(512, 2) fwd_kernel(Params p_arg) {
    (void)p_arg; PP p = (PP)__builtin_amdgcn_kernarg_segment_ptr();
    extern __shared__ __attribute__((aligned(16))) unsigned char lds_raw[];
    Frame F;
    F.lds = (LAS unsigned char*)lds_raw; F.MISC = (volatile LAS unsigned*)(F.lds + MISC_OFF);
    F.tid = threadIdx.x; F.lane = F.tid & 63; F.wave = __builtin_amdgcn_readfirstlane(F.tid >> 6);
    F.G = gridDim.x; { const int bx = blockIdx.x; F.vcu = (F.G % 8 == 0) ? (bx % 8) * (F.G / 8) + bx / 8 : bx; }
    F.ctl = (gu32*)(p->ws + WS_CTL);
    for (int u = F.tid; u < (LDS_BYTES - MISC_OFF) / 4; u += 512) ((LAS unsigned*)(F.lds + MISC_OFF))[u] = 0u;
    __syncthreads();
    XcdBarrier bar; bar.bar = (unsigned*)(F.ctl + CW_BAR); bar.x = 0; bar.st = nullptr;
    if (!MK_PER_PHASE) bar = xcd_barrier_post((unsigned*)(F.ctl + CW_BAR), F.MISC + 8);
    const int lo = p->ph_lo, hi = p->ph_hi;
#ifndef PHMASK
#define PHMASK 0xFFF
#endif
#define IN(k) (((PHMASK >> (k)) & 1) && lo <= (k) && (k) < hi)
#define GRID_BAR(k) do { if (IN(k) && IN((k) + 1)) xcd_barrier(bar); } while (0)
    bf16* const WIN = (bf16*)(p->ws + WS_WIN); bf16* const WOUT = (bf16*)(p->ws + WS_WOUT); bf16* const WQ = (bf16*)(p->ws + WS_WQ); bf16* const WKV = (bf16*)(p->ws + WS_WKV);
    bf16* const WO = (bf16*)(p->ws + WS_WO); bf16* const WF = (bf16*)(p->ws + WS_WF); bf16* const WR = (bf16*)(p->ws + WS_WR); bf16* const WUP = (bf16*)(p->ws + WS_WUP); bf16* const WDN = (bf16*)(p->ws + WS_WDN);
    bf16* const H0 = (bf16*)(p->ws + WS_H0); bf16* const MEMN = (bf16*)(p->ws + WS_MEMN); bf16* const PB = (bf16*)(p->ws + WS_P); bf16* const OB = (bf16*)(p->ws + WS_O);
    float* const RB = (float*)(p->ws + WS_R); bf16* const H1 = (bf16*)(p->ws + WS_H1); bf16* const H2 = (bf16*)(p->ws + WS_H2); bf16* const OX = (bf16*)(p->ws + WS_OX);
    bf16* const ACT = (bf16*)(p->ws + WS_ACT); bf16* const YB = (bf16*)(p->ws + WS_Y);
    const int gw = F.vcu * 8 + F.wave, NGW = F.G * 8;

    for (int rep_ = 0; rep_ < ((PROBE_REP == 0) ? 2 : 1); ++rep_) { if (rep_) xcd_barrier(bar);
    if (IN(0)) {
        F.fresh(); P_FRESH(p);
        LAS unsigned char* scr = F.lds + F.wave * TR_WAVE_BYTES;
        tr_run(p, 0, NITEMS_DENSE, gw, NGW, scr, F.lane);
        { LAS float* scr32 = (LAS float*)scr;
          for (int it = gw; it < 64; it += NGW) tr_item(p->router_w, NE, 64 * it, 0, WR, DM, 0, scr32, F.lane); }
        for (int idx = (int)blockIdx.x * 512 + F.tid; idx < 16 * DM; idx += F.G * 512) { const int k = idx >> 4, n = idx & 15; WF[(size_t)n * DM + k] = (bf16)f2bf(p->w_in[(size_t)k * N_IN_SRC + 8192 + n]); }
        ln_rows_f32(p->x, p->ln_in_g, p->ln_in_b, H0, gw, NGW, NTOK, F.lane);
        ln_rows_f32(p->mem, p->mem_ln_g, p->mem_ln_b, MEMN, gw, NGW, NB * NMEM, F.lane);
    }
    }
    GRID_BAR(0);

    for (int rep_ = 0; rep_ < ((PROBE_REP == 1) ? 2 : 1); ++rep_) { if (rep_) xcd_barrier(bar);
    if (IN(1)) {
        F.fresh(); P_FRESH(p);
        pg8::DenseSched S; S.init(H0, WIN, DM * 2, DM * 2, NTOK, NP, F.G, (int)blockIdx.x);
        pg8::EpiBf16 E{PB, NP};
        const int slot = ((int)blockIdx.x >> 3) & 7;
        S.ib = 0; S.ie = slot;
        pg8::gemm_phase<pg8::EpiBf16, pg8::DenseSched, true, false>(F.lds, DM * 2, DM * 2, DM * 2, S, E);
        __syncthreads();
        tr_run(p, NITEMS_DENSE, NITEMS, gw, NGW, F.lds + F.wave * TR_WAVE_BYTES, F.lane);
        __syncthreads();
        S.ib = slot; S.ie = 1 << 30;
        pg8::gemm_phase<pg8::EpiBf16, pg8::DenseSched, true, false>(F.lds, DM * 2, DM * 2, DM * 2, S, E);
        for (int rb = blockIdx.x; rb < NTOK / 32; rb += F.G) flogit_rows(F, p, 32 * rb);
    }
    }
    GRID_BAR(1);

    for (int rep_ = 0; rep_ < ((PROBE_REP == 2) ? 2 : 1); ++rep_) { if (rep_) xcd_barrier(bar);
    if (IN(2)) {
        F.fresh(); P_FRESH(p);
        for (int pid = F.vcu; pid < 256; pid += F.G) {
            const int bh = pid >> 2, b = bh >> 4, h = bh & 15, q0 = pid & 3;
            fox_tables(F, p, b, h);
#pragma unroll 1
            for (int rep = 0; rep < 2; ++rep) attn_unit<0>(F, p, b, h, rep ? q0 : 7 - q0);
#pragma unroll 1
            for (int rep = 0; rep < 2; ++rep) attn_unit<1>(F, p, b, h, rep ? q0 : 7 - q0);
        }
    }
    }
    GRID_BAR(2);

    for (int rep_ = 0; rep_ < ((PROBE_REP == 3) ? 2 : 1); ++rep_) { if (rep_) xcd_barrier(bar);
    if (IN(3)) {
        F.fresh(); P_FRESH(p);
        pg8::DenseSched S; S.init(OB, WOUT, DM * 2, DM * 2, NTOK, DM, F.G, (int)blockIdx.x);
        pg8::EpiRes E{RB, H0, DM, DN_ALPHA};
        pg8::gemm_phase<pg8::EpiRes, pg8::DenseSched, true, false>(F.lds, DM * 2, DM * 2, DM * 2, S, E);
    }
    }
    GRID_BAR(3);

    for (int rep_ = 0; rep_ < ((PROBE_REP == 4) ? 2 : 1); ++rep_) { if (rep_) xcd_barrier(bar);
    if (IN(4)) {
        F.fresh(); P_FRESH(p);
        const int nkv = (F.G >= 128) ? 64 : 0;
        if ((int)blockIdx.x < nkv || nkv == 0) {
            for (int c = blockIdx.x; c < 64; c += (nkv ? 64 : F.G)) {
                pg8::SplitKSched S{(const char*)MEMN, (const char*)WKV, DM * 2, DM * 2, 4, 4, QSPLIT, QKS, c};
                pg8::EpiSlab E{(float*)(p->ws + WS_KVS), 2 * XW, (size_t)NB * NMEM * 2 * XW};
                pg8::gemm_phase<pg8::EpiSlab, pg8::SplitKSched, false, false>(F.lds, QKS * 2, DM * 2, DM * 2, S, E);
                if (nkv) break;
            }
        }
        if ((int)blockIdx.x >= nkv) { const int nw = (F.G - nkv) * 8, w0 = ((int)blockIdx.x - nkv) * 8 + F.wave;
            ln_rows_f32(RB, p->ln_mix_g, p->ln_mix_b, H1, w0, nw, NTOK, F.lane); }
    }
    }
    GRID_BAR(4);

    for (int rep_ = 0; rep_ < ((PROBE_REP == 5) ? 2 : 1); ++rep_) { if (rep_) xcd_barrier(bar);
    if (IN(5)) {
        F.fresh(); P_FRESH(p);
        for (int c = blockIdx.x; c < 256; c += F.G) {
            pg8::SplitKSched S{(const char*)H1, (const char*)WQ, DM * 2, DM * 2, NTOK / 256, 2, QSPLIT, QKS, c};
            pg8::EpiSlab E{(float*)(p->ws + WS_QS), XW, (size_t)NTOK * XW};
            pg8::gemm_phase<pg8::EpiSlab, pg8::SplitKSched, false, false>(F.lds, QKS * 2, DM * 2, DM * 2, S, E);
        }
        { const float* KVS = (const float*)(p->ws + WS_KVS); bf16* KVB = (bf16*)(p->ws + WS_KVB);
          for (int i = (int)blockIdx.x * 512 + F.tid; i < NB * NMEM * 2 * XW / 4; i += F.G * 512) { f32x4 a = {0.f, 0.f, 0.f, 0.f};
#pragma unroll
              for (int s = 0; s < QSPLIT; ++s) a += ((const GAS f32x4*)(KVS + (size_t)s * NB * NMEM * 2 * XW))[i];
              ((GAS u32x2*)KVB)[i] = (u32x2){cvt_pk_bf16(a[0], a[1]), cvt_pk_bf16(a[2], a[3])}; } }
    }
    }
    GRID_BAR(5);

    for (int rep_ = 0; rep_ < ((PROBE_REP == 6) ? 2 : 1); ++rep_) { if (rep_) xcd_barrier(bar);
    if (IN(6)) {
        F.fresh(); P_FRESH(p);
        for (int u = F.vcu; u < 256; u += F.G) xattn_unit(F, p, u >> 6, (u >> 4) & 3, u & 15);
    }
    }
    GRID_BAR(6);

    for (int rep_ = 0; rep_ < ((PROBE_REP == 7) ? 2 : 1); ++rep_) { if (rep_) xcd_barrier(bar);
    if (IN(7)) {
        F.fresh(); P_FRESH(p);
        pg8::DenseSched S; S.init(OX, WO, XW * 2, XW * 2, NTOK, DM, F.G, (int)blockIdx.x);
        pg8::EpiRes E{RB, H1, DM, DN_ALPHA};
        pg8::gemm_phase<pg8::EpiRes, pg8::DenseSched, true, false>(F.lds, XW * 2, XW * 2, XW * 2, S, E);
    }
    }
    GRID_BAR(7);

    for (int rep_ = 0; rep_ < ((PROBE_REP == 8) ? 2 : 1); ++rep_) { if (rep_) xcd_barrier(bar);
    if (IN(8)) {
        F.fresh(); P_FRESH(p);
        for (int rb = blockIdx.x; rb < NTOK / 32; rb += F.G) {
            ln_rows_f32(RB, p->ln_xa_g, p->ln_xa_b, H2, 32 * rb + 4 * F.wave, 1, 32 * rb + 4 * F.wave + 4, F.lane, p->ws + WS_H2F8);
            VM_WAIT(); __syncthreads();
            if (F.wave == 0) { __builtin_amdgcn_fence(__ATOMIC_RELEASE, "agent"); __builtin_amdgcn_fence(__ATOMIC_ACQUIRE, "agent"); VM_WAIT(); }
            __syncthreads();
            router_rows(F, p, 32 * rb);
        }
    }
    }
    GRID_BAR(8);

    for (int rep_ = 0; rep_ < ((PROBE_REP == 9) ? 2 : 1); ++rep_) { if (rep_) xcd_barrier(bar);
    if (IN(9)) {
        F.fresh(); P_FRESH(p);
        moe_tables(F, p, 8, true);
        LAS const int* tab = (LAS const int*)(F.lds + LDSX_OFF);
        pg8::MoeSched S{(const char*)(p->ws + WS_H2F8), (const char*)WUP, (size_t)(2 * DE) * DM, DM, DM, 8, F.G, (int)blockIdx.x, tab, true};
        pg8::EpiUp E{(unsigned char*)ACT, p->b_up, tab};
        pg8::gemm_phase<pg8::EpiUp, pg8::MoeSched, true, true, true>(F.lds, DM, DM, DM, S, E, E8_H2, E8_W);
    }
    }
    GRID_BAR(9);

    for (int rep_ = 0; rep_ < ((PROBE_REP == 10) ? 2 : 1); ++rep_) { if (rep_) xcd_barrier(bar);
    if (IN(10)) {
        F.fresh(); P_FRESH(p);
        moe_tables(F, p, 16, false);
        LAS const int* tab = (LAS const int*)(F.lds + LDSX_OFF);
        pg8::MoeSched S{(const char*)ACT, (const char*)WDN, (size_t)DM * DE, DE, DE, 16, F.G, (int)blockIdx.x, tab, false};
        pg8::EpiDown E{YB, p->b_down, (const int*)(p->ws + WS_LIST), (const float*)(p->ws + WS_GATE), tab};
        pg8::gemm_phase<pg8::EpiDown, pg8::MoeSched, true, false, true>(F.lds, DE, DE, DE, S, E, E8_ACT, E8_W);
    }
    }
    GRID_BAR(10);

    for (int rep_ = 0; rep_ < ((PROBE_REP == 11) ? 2 : 1); ++rep_) { if (rep_) xcd_barrier(bar);
    if (IN(11)) {
        F.fresh(); P_FRESH(p);
        const unsigned bad = __hip_atomic_load(F.ctl + CW_BAR + XB_TMO, RLX_AGENT);
        const int half = F.wave & 1, rs = F.wave >> 1; LAS float* st = (LAS float*)F.lds;
        const int nsteps = (NTOK / 4 + F.G - 1) / F.G;
        u32x2 nh[8], ny[4][8];
#define P11_LOAD(m) do { const GAS u32x2* hp_ = (const GAS u32x2*)(H2 + (size_t)(m) * DM + half * 2048) + F.lane; \
            _Pragma("unroll") for (int j = 0; j < 8; ++j) nh[j] = hp_[64 * j]; \
            _Pragma("unroll") for (int k = 0; k < 4; ++k) { const GAS u32x2* yp_ = (const GAS u32x2*)(YB + ((size_t)(m) * 4 + k) * DM + half * 2048) + F.lane; \
                _Pragma("unroll") for (int j = 0; j < 8; ++j) ny[k][j] = yp_[64 * j]; } } while (0)
        int grp = F.vcu;
        if (grp * 4 < NTOK) P11_LOAD(grp * 4 + rs);
        for (int it = 0; it < nsteps; ++it) {
            const int m = grp * 4 + rs; const bool live = grp * 4 < NTOK;
            f32x4 v[8]; float s1 = 0.f, s2 = 0.f;
#pragma unroll
            for (int j = 0; j < 8; ++j) { f32x4 a = {DN_ALPHA * bflo(nh[j].x), DN_ALPHA * bfhi(nh[j].x), DN_ALPHA * bflo(nh[j].y), DN_ALPHA * bfhi(nh[j].y)};
#pragma unroll
                for (int k = 0; k < 4; ++k) { a[0] += bflo(ny[k][j].x); a[1] += bfhi(ny[k][j].x); a[2] += bflo(ny[k][j].y); a[3] += bfhi(ny[k][j].y); }
                v[j] = a; s1 += (a[0] + a[1]) + (a[2] + a[3]); s2 += (a[0] * a[0] + a[1] * a[1]) + (a[2] * a[2] + a[3] * a[3]); }
            grp += F.G;
            if (grp * 4 < NTOK) P11_LOAD(grp * 4 + rs);
            s1 = wave_sum(s1); s2 = wave_sum(s2);
            if (F.lane == 0) { st[(it & 1) * 16 + F.wave * 2] = s1; st[(it & 1) * 16 + F.wave * 2 + 1] = s2; }
            __syncthreads();
            const float t1 = s1 + st[(it & 1) * 16 + (F.wave ^ 1) * 2], t2 = s2 + st[(it & 1) * 16 + (F.wave ^ 1) * 2 + 1];
            const float mean = t1 * (1.f / DM); const float var = fmaxf(t2 * (1.f / DM) - mean * mean, 0.f); const float rstd = 1.f / sqrtf(var + LN_EPS);
            if (live) { const GAS f32x4* g4 = (const GAS f32x4*)(p->ln_moe_g + half * 2048) + F.lane; const GAS f32x4* b4 = (const GAS f32x4*)(p->ln_moe_b + half * 2048) + F.lane;
                GAS f32x4* o4 = (GAS f32x4*)(p->out + (size_t)m * DM + half * 2048) + F.lane;
#pragma unroll
                for (int j = 0; j < 8; ++j) { f32x4 y = (v[j] - mean) * rstd * g4[64 * j] + b4[64 * j]; if (bad) y[0] = __builtin_nanf(""); o4[64 * j] = y; } }
        }
#undef P11_LOAD
    }
    }
#undef IN
#undef GRID_BAR
}

extern "C" void kernel_launch(void* const* d_in, const int* in_sizes, int n_in, void* d_out, int out_size, void* d_ws, size_t ws_size, hipStream_t stream) {
    static int grid = 0;
    if (grid == 0) {
        if (n_in != 27 || out_size != NTOK * DM || ws_size < WS_END) { fprintf(stderr, "kernel_launch: unexpected problem shape (n_in %d, out %d, ws %zu)\n", n_in, out_size, ws_size); grid = -1; return; }
        int dev = 0, cus = 0, per_cu = 0;
        if (hipGetDevice(&dev) != hipSuccess || hipDeviceGetAttribute(&cus, hipDeviceAttributeMultiprocessorCount, dev) != hipSuccess) { grid = -1; return; }
        if (hipFuncSetAttribute((const void*)fwd_kernel, hipFuncAttributeMaxDynamicSharedMemorySize, LDS_BYTES) != hipSuccess) { fprintf(stderr, "kernel_launch: hipFuncSetAttribute failed\n"); grid = -1; return; }
        if (hipOccupancyMaxActiveBlocksPerMultiprocessor(&per_cu, (const void*)fwd_kernel, 512, LDS_BYTES) != hipSuccess || per_cu < 1) fprintf(stderr, "kernel_launch: occupancy query reports %d blocks per CU\n", per_cu);
        (void)hipGetLastError();
        grid = cus;
    }
    if (grid < 0) return;
    (void)hipMemsetAsync((char*)d_ws + WS_CTL, 0, CTL_ZERO_BYTES, stream);
    Params p{};
    const float** pp = (const float**)&p;
    for (int i = 0; i < 27; ++i) pp[i] = (const float*)d_in[i];
    p.out = (float*)d_out; p.ws = (unsigned char*)d_ws;
#if MK_PER_PHASE
    for (int k = 0; k < N_PHASES; ++k) { p.ph_lo = k; p.ph_hi = k + 1; hipLaunchKernelGGL(fwd_kernel, dim3(grid), dim3(512), LDS_BYTES, stream, p); }
#else
    p.ph_lo = 0; p.ph_hi = N_PHASES;
    hipLaunchKernelGGL(fwd_kernel, dim3(grid), dim3(512), LDS_BYTES, stream, p);
#endif
}
```

```cpp
#include <hip/hip_runtime.h>
#include <cstdio>
#include <cstdint>

#ifndef PROBE_REP
#define PROBE_REP -1
#endif
#ifndef MK_PER_PHASE
#define MK_PER_PHASE 0
#endif

#define GAS __attribute__((address_space(1)))
#define LAS __attribute__((address_space(3)))
typedef unsigned short bf16;
typedef short bf16x8 __attribute__((ext_vector_type(8)));
typedef short s16x4 __attribute__((ext_vector_type(4)));
typedef short v4i16_t __attribute__((ext_vector_type(4)));
typedef float f32x4 __attribute__((ext_vector_type(4)));
typedef float f32x2 __attribute__((ext_vector_type(2)));
typedef float f32x16 __attribute__((ext_vector_type(16)));
typedef unsigned u32x4 __attribute__((ext_vector_type(4)));
typedef unsigned u32x2 __attribute__((ext_vector_type(2)));
typedef int v8i __attribute__((ext_vector_type(8)));
typedef int v4i __attribute__((ext_vector_type(4)));
typedef GAS unsigned gu32;
#define RLX_AGENT __ATOMIC_RELAXED, __HIP_MEMORY_SCOPE_AGENT
#define LDS_WAIT() asm volatile("s_waitcnt lgkmcnt(0)" ::: "memory")
#define VM_WAIT() asm volatile("s_waitcnt vmcnt(0)" ::: "memory")
#define SBAR() __builtin_amdgcn_sched_barrier(0)

constexpr int NB = 4, SEQ = 2048, DM = 4096, NTOK = NB * SEQ, HD = 128, NFH = 16, NSH = 16;
constexpr int NP = 14336;
constexpr int PC_QF = 0, PC_KF = 2048, PC_VF = 4096, PC_GF = 6144, PC_QS = 8192, PC_KS = 10240, PC_VS = 12288;
constexpr int N_IN_SRC = 14352;
constexpr int NMEM = 256, XH = 4, XW = 512;
constexpr int NE = 32, TOPK = 4, DE = 1024;
constexpr float LN_EPS = 1e-5f, RMS_EPS = 1e-6f;
constexpr float DN_ALPHA = 1.189207115002721f;
constexpr float LOG2E = 1.4426950408889634f;
constexpr float C2 = 0.08838834764831845f * 1.4426950408889634f;
constexpr int QSPLIT = 4, QKS = DM / QSPLIT;

constexpr size_t MiB = 1u << 20;
constexpr size_t WS_CTL = 0, CTL_ZERO_BYTES = 1 * MiB;
constexpr size_t WS_WIN = 16 * MiB;
constexpr size_t WS_WOUT = 128 * MiB;
constexpr size_t WS_WQ = 160 * MiB, WS_WKV = 164 * MiB, WS_WO = 172 * MiB, WS_WF = 176 * MiB, WS_WR = 177 * MiB;
constexpr size_t WS_WUP = 192 * MiB;
constexpr size_t WS_H2F8 = 448 * MiB;
constexpr size_t WS_WDN = 704 * MiB;
constexpr size_t WS_H0 = 960 * MiB, WS_MEMN = 1024 * MiB;
constexpr size_t WS_P = 1040 * MiB;
constexpr size_t WS_FL = 1264 * MiB;
constexpr size_t WS_O = 1272 * MiB;
constexpr size_t WS_R = 1336 * MiB;
constexpr size_t WS_H1 = 1464 * MiB;
constexpr size_t WS_KVS = 1528 * MiB;
constexpr size_t WS_QS = 1544 * MiB;
constexpr size_t WS_OX = 1608 * MiB;
constexpr size_t WS_H2 = 1616 * MiB;
constexpr size_t WS_LIST = 1680 * MiB;
constexpr size_t WS_GATE = 1682 * MiB;
constexpr size_t WS_KVB = 1684 * MiB;
constexpr size_t WS_ACT = 1688 * MiB;
constexpr size_t WS_Y = 1768 * MiB;
constexpr size_t WS_END = 2024 * MiB;
constexpr int CW_TMO = 0;
constexpr int CW_BAR = 4096;
constexpr int CW_CNT = 65536;

constexpr int RING_BYTES = 131072;
constexpr int LDSX_OFF = RING_BYTES;
constexpr int MISC_OFF = RING_BYTES + 12288;
constexpr int LDS_BYTES = 147456;

__device__ __forceinline__ unsigned f2bf(float f) { unsigned u = __builtin_bit_cast(unsigned, f); return (u + 0x7fffu + ((u >> 16) & 1u)) >> 16; }
__device__ __forceinline__ unsigned pk2(float lo, float hi) { return f2bf(lo) | (f2bf(hi) << 16); }
__device__ __forceinline__ float bf2f(unsigned short b) { return __builtin_bit_cast(float, (unsigned)b << 16); }
__device__ __forceinline__ float bflo(unsigned w) { return __builtin_bit_cast(float, w << 16); }
__device__ __forceinline__ float bfhi(unsigned w) { return __builtin_bit_cast(float, w & 0xffff0000u); }
__device__ __forceinline__ unsigned cvt_pk_bf16(float lo, float hi) { unsigned r; asm volatile("v_cvt_pk_bf16_f32 %0, %1, %2" : "=v"(r) : "v"(lo), "v"(hi)); return r; }
constexpr float F8S_H2 = 16.f, F8S_W = 1024.f, F8S_ACT = 4.f;
constexpr int E8_H2 = 0x7B7B7B7B, E8_W = 0x75757575, E8_ACT = 0x7D7D7D7D;
__device__ __forceinline__ unsigned pk4_fp8(float a, float b, float c, float d) { int w = 0; w = __builtin_amdgcn_cvt_pk_fp8_f32(a, b, w, false); w = __builtin_amdgcn_cvt_pk_fp8_f32(c, d, w, true); return (unsigned)w; }
__device__ __forceinline__ float wave_sum(float v) {
#pragma unroll
    for (int o = 1; o < 64; o <<= 1) v += __shfl_xor(v, o);
    return v;
}

#define XB_TMO      128
#define XB_XCNT(j)  (256  + 64 * (j))
#define XB_XSUB(j)  (1280 + 64 * (j))
#define XB_XGEN(j)  (2304 + 64 * (j))
#define XB_TOP      3328
#define XB_TOPGEN   3392
#define XCD_BAR_WORDS 3456
#define XB_SPIN_CAP (1u << 18)
__device__ __forceinline__ unsigned xb_ld(unsigned* p)              { return __hip_atomic_load(p, __ATOMIC_RELAXED, __HIP_MEMORY_SCOPE_AGENT); }
__device__ __forceinline__ unsigned xb_add(unsigned* p, unsigned v) { return __hip_atomic_fetch_add(p, v, __ATOMIC_RELAXED, __HIP_MEMORY_SCOPE_AGENT); }
__device__ __forceinline__ unsigned xb_xcc_id() { return (unsigned)__builtin_amdgcn_s_getreg((3 << 11) | 20) & 0xFu; }
#define XB_SPIN(cond, bar) do { unsigned _sp = 0; while (cond) { __builtin_amdgcn_s_sleep(1); \
    if ((++_sp & 255u) == 0u) { if (xb_ld(&(bar)[XB_TMO])) break; if (_sp > XB_SPIN_CAP) { atomicAdd(&(bar)[XB_TMO], 1u); break; } } } } while (0)
struct XcdBarrier { unsigned* bar; unsigned x; volatile LAS unsigned* st; };
__device__ __forceinline__ XcdBarrier xcd_barrier_post(unsigned* bar, volatile LAS unsigned* st) {
    XcdBarrier b; b.bar = bar; b.x = xb_xcc_id(); b.st = st;
    if (threadIdx.x == 0) (void)xb_add(&bar[XB_XCNT(b.x)], 1u);
    return b;
}
__device__ __forceinline__ void xcd_barrier_complete(unsigned* bar, unsigned x, unsigned& nloc, unsigned& nx) {
    const unsigned G = gridDim.x * gridDim.y * gridDim.z;
    unsigned sum, cnt, mine, sp = 0u;
    for (;;) {
        sum = 0u; cnt = 0u; mine = 0u;
#pragma unroll
        for (unsigned j = 0; j < 16; ++j) { const unsigned c = xb_ld(&bar[XB_XCNT(j)]); sum += c; cnt += (c > 0u) ? 1u : 0u; mine = (j == x) ? c : mine; }
        if (sum == G) break;
        __builtin_amdgcn_s_sleep(1);
        if ((++sp & 255u) == 0u) { if (xb_ld(&bar[XB_TMO])) break; if (sp > XB_SPIN_CAP) { atomicAdd(&bar[XB_TMO], 1u); break; } }
    }
    nloc = mine > 0u ? mine : 1u; nx = cnt > 0u ? cnt : 1u;
}
__device__ __forceinline__ void xcd_barrier(const XcdBarrier& b) {
    asm volatile("s_waitcnt vmcnt(0)" ::: "memory");
    __syncthreads();
    if (threadIdx.x == 0) {
        unsigned* bar = b.bar;
        __builtin_amdgcn_s_waitcnt(0);
        unsigned nloc = b.st[0], nx = b.st[1];
        if (nloc == 0u) { xcd_barrier_complete(bar, b.x, nloc, nx); b.st[0] = nloc; b.st[1] = nx; }
        const unsigned old = xb_add(&bar[XB_XSUB(b.x)], 1u);
        const unsigned gen = old / nloc;
        if (old + 1u == (gen + 1u) * nloc) {
            __builtin_amdgcn_fence(__ATOMIC_RELEASE, "agent");
            asm volatile("s_waitcnt vmcnt(0)" ::: "memory");
            const unsigned og = xb_add(&bar[XB_TOP], 1u);
            const unsigned tg = og / nx;
            if (og + 1u == (tg + 1u) * nx) xb_add(&bar[XB_TOPGEN], 1u);
            else XB_SPIN(xb_ld(&bar[XB_TOPGEN]) == tg, bar);
            __builtin_amdgcn_fence(__ATOMIC_ACQUIRE, "agent");
            xb_add(&bar[XB_XGEN(b.x)], 1u);
            asm volatile("s_waitcnt vmcnt(0)" ::: "memory");
        } else {
            XB_SPIN(xb_ld(&bar[XB_XGEN(b.x)]) == gen, bar);
            __builtin_amdgcn_fence(__ATOMIC_ACQUIRE, "agent");
            asm volatile("s_waitcnt vmcnt(0)" ::: "memory");
        }
    }
    __syncthreads();
}

namespace pg8 {
constexpr int BM = 256, BK = 64, HALF = 128, HTB = HALF * BK * 2, NXCD = 8, WGM = 8;
__host__ __device__ __forceinline__ int lds_byte(int r, int c) { const int st = (r >> 4) * 2 + (c >> 5), rr = r & 15, cc = c & 31, ob = rr * 64 + cc * 2; return st * 1024 + (ob ^ (((ob >> 9) & 1) << 5)); }
__host__ __device__ __forceinline__ void stage_rc(int b, int& R, int& C) { const int st = b / 1024, sb = b % 1024, swz = sb ^ (((sb >> 9) & 1) << 5); R = (st >> 1) * 16 + swz / 64; C = (st & 1) * 32 + (swz % 64) / 2; }
__host__ __device__ __forceinline__ int perm32(int rho) { const int n = rho >> 4, i = rho & 15; return 8 * (i >> 2) + 4 * n + (i & 3); }
__device__ __forceinline__ int xcd_remap(int L, int nwg) { const int q = nwg / NXCD, r = nwg % NXCD, xcd = L % NXCD, off = L / NXCD; return (xcd < r ? xcd * (q + 1) : r * (q + 1) + (xcd - r) * q) + off; }

struct Unit { int pm, pn, e, aux; };

struct DenseSched {
    const char* A; const char* Bt; int lda, ldb, nM, nN, nwg, G, c, ib, ie;
    __device__ void init(const void* A_, const void* Bt_, int lda_, int ldb_, int M, int N, int G_, int c_) { A = (const char*)A_; Bt = (const char*)Bt_; lda = lda_; ldb = ldb_; nM = M / BM; nN = N / BM; nwg = nM * nN; G = G_; c = c_; ib = 0; ie = 1 << 30; }
    __device__ __forceinline__ bool next(int i0, Unit& u) const {
        const int i = i0 + ib; if (i >= ie) return false;
        const long L = (long)i * G + c; if (L >= nwg) return false;
        const int wgid = xcd_remap((int)L, nwg);
        const int nig = WGM * nN, gid = wgid / nig, fm = gid * WGM, gsz = (nM - fm) < WGM ? (nM - fm) : WGM;
        u.pm = fm + ((wgid % nig) % gsz); u.pn = (wgid % nig) / gsz; u.e = 0; u.aux = i; return true;
    }
    __device__ __forceinline__ int a_off(const Unit& u) const { return u.pm * BM * lda; }
    __device__ __forceinline__ int b_off(const Unit& u) const { return u.pn * BM * ldb; }
    __device__ __forceinline__ int arow(const Unit&, int pos) const { return pos; }
};
struct SplitKSched {
    const char* A; const char* Bt; int lda, ldb, nM, nN, nS, ks, c;
    __device__ __forceinline__ bool next(int i, Unit& u) const {
        if (i > 0 || c < 0 || c >= nM * nN * nS) return false;
        u.e = c % nS; const int t = c / nS; u.pn = t % nN; u.pm = t / nN; u.aux = 0; return true;
    }
    __device__ __forceinline__ int a_off(const Unit& u) const { return u.pm * BM * lda + u.e * ks * 2; }
    __device__ __forceinline__ int b_off(const Unit& u) const { return u.pn * BM * ldb + u.e * ks * 2; }
    __device__ __forceinline__ int arow(const Unit&, int pos) const { return pos; }
};

template <class Epi, class Sched, bool ALIGN_EPI, bool GATHER, bool FP8 = false>
__device__ __forceinline__ void gemm_phase(LAS unsigned char* lds, const int KB, const int lda, const int ldb, const Sched& S, const Epi& E, const int sclA = 0x7F7F7F7F, const int sclB = 0x7F7F7F7F) {
    int tid_ = threadIdx.x; asm volatile("" : "+v"(tid_));
    const int tid = tid_, wid = __builtin_amdgcn_readfirstlane(tid >> 6), lane = tid & 63, wr = wid >> 2, wc = wid & 3, fr = lane & 15, fq = lane >> 4;
    const int nt = KB / (BK * 2);
    int R0, C0; stage_rc(tid * 16, R0, C0);
    unsigned voffB[2];
    { const int R1 = R0 + 64; const int Rb0 = Epi::PERM ? ((R0 & ~31) + perm32(R0 & 31)) : R0, Rb1 = Epi::PERM ? ((R1 & ~31) + perm32(R1 & 31)) : R1;
      voffB[0] = (unsigned)(Rb0 * ldb + C0 * 2); voffB[1] = (unsigned)(Rb1 * ldb + C0 * 2); }
    const int kstep = BK * 2;
    const int hstepB = HALF * ldb;
    const __amdgpu_buffer_rsrc_t rsA = __builtin_amdgcn_make_buffer_rsrc((void*)S.A, (short)0, (int)0xFFFFFFFFu, 0x00020000);
    const __amdgpu_buffer_rsrc_t rsB = __builtin_amdgcn_make_buffer_rsrc((void*)S.Bt, (short)0, (int)0xFFFFFFFFu, 0x00020000);
    const unsigned ldsw = (unsigned)wid * 1024u;
    const int aoff = lds_byte(wr * 64 + fr, fq * 8), boff = lds_byte(wc * 32 + fr, fq * 8);
#define PG8_SA(b, h) (((b) * 2 + (h)) * HTB)
#define PG8_SB(b, h) ((4 + (b) * 2 + (h)) * HTB)
#define PG8_ST2(bufoff, rs, soff, o0, o1) do { const int so_ = (soff); \
        __builtin_amdgcn_raw_ptr_buffer_load_lds(rs, (LAS unsigned*)(lds + (bufoff) + ldsw), 16, (int)(o0), so_, 0, 0); \
        __builtin_amdgcn_raw_ptr_buffer_load_lds(rs, (LAS unsigned*)(lds + (bufoff) + ldsw + 8192), 16, (int)(o1), so_, 0, 0); } while (0)
#define PG8_STB(b, h, soff) PG8_ST2(PG8_SB(b, h), rsB, (soff) + (h) * hstepB, voffB[0], voffB[1])
#define PG8_STA(b, h, soff, V) PG8_ST2(PG8_SA(b, h), rsA, (soff), V[2 * (h)], V[2 * (h) + 1])
#define PG8_LDA(dst, b, h) do { _Pragma("unroll") for (int m = 0; m < 4; ++m) { if constexpr (FP8) { \
            dst##8[m] = __builtin_shufflevector(*(const LAS v4i*)(lds + PG8_SA(b, h) + aoff + m * 2048), *(const LAS v4i*)(lds + PG8_SA(b, h) + aoff + m * 2048 + 1024), 0, 1, 2, 3, 4, 5, 6, 7); } \
        else { _Pragma("unroll") for (int k = 0; k < 2; ++k) dst[m][k] = *(const LAS bf16x8*)(lds + PG8_SA(b, h) + aoff + m * 2048 + k * 1024); } } } while (0)
#define PG8_LDB(dst, b, h) do { _Pragma("unroll") for (int n = 0; n < 2; ++n) { if constexpr (FP8) { \
            dst##8[n] = __builtin_shufflevector(*(const LAS v4i*)(lds + PG8_SB(b, h) + boff + n * 2048), *(const LAS v4i*)(lds + PG8_SB(b, h) + boff + n * 2048 + 1024), 0, 1, 2, 3, 4, 5, 6, 7); } \
        else { _Pragma("unroll") for (int k = 0; k < 2; ++k) dst[n][k] = *(const LAS bf16x8*)(lds + PG8_SB(b, h) + boff + n * 2048 + k * 1024); } } } while (0)
#define PG8_MMA(ai, bj, At, Bt) do { __builtin_amdgcn_s_setprio(1); _Pragma("unroll") for (int m = 0; m < 4; ++m) _Pragma("unroll") for (int n = 0; n < 2; ++n) { \
        if constexpr (FP8) { asm volatile("v_mfma_scale_f32_16x16x128_f8f6f4 %0, %1, %2, %0, %3, %4 op_sel_hi:[0,0,0]" : "+v"(acc[ai][bj][m][n]) : "v"(Bt##8[n]), "v"(At##8[m]), "v"(sclB), "v"(sclA)); }   \
        else { _Pragma("unroll") for (int k = 0; k < 2; ++k) acc[ai][bj][m][n] = __builtin_amdgcn_mfma_f32_16x16x32_bf16(Bt[n][k], At[m][k], acc[ai][bj][m][n], 0, 0, 0); } } \
        __builtin_amdgcn_s_setprio(0); } while (0)
#define PG8_WAIT_V(n) asm volatile("s_waitcnt vmcnt(" #n ")" ::: "memory")
#define PG8_WAIT_L(n) asm volatile("s_waitcnt lgkmcnt(" #n ")" ::: "memory")
#define PG8_BAR __builtin_amdgcn_s_barrier()
#define PG8_SCHED __builtin_amdgcn_sched_barrier(0)
    Unit cur, nxt; int ui = 0;
    if (!S.next(0, cur)) return;
    unsigned vA[4], vAn[4];
#pragma unroll
    for (int j = 0; j < 4; ++j) { const int pos = (j >> 1) * HALF + R0 + (j & 1) * 64; vA[j] = (unsigned)(S.arow(cur, pos) * lda + C0 * 2); vAn[j] = vA[j]; }
    f32x4 acc[2][2][4][2];
#pragma unroll
    for (int a = 0; a < 2; ++a)
#pragma unroll
        for (int b = 0; b < 2; ++b)
#pragma unroll
            for (int m = 0; m < 4; ++m)
#pragma unroll
                for (int n = 0; n < 2; ++n) acc[a][b][m][n] = (f32x4){0.f, 0.f, 0.f, 0.f};
    bf16x8 At[4][2], B0[2][2], B1[2][2]; v8i At8[4], B08[2], B18[2];
    int cA = __builtin_amdgcn_readfirstlane(S.a_off(cur)), cB = __builtin_amdgcn_readfirstlane(S.b_off(cur));
    PG8_STB(0, 0, cB); PG8_STB(0, 1, cB); PG8_STA(0, 0, cA, vA); PG8_STA(0, 1, cA, vA);
    if (wr == 1) PG8_BAR;
    PG8_WAIT_V(2); PG8_BAR;
    PG8_STB(1, 0, cB + kstep); PG8_STA(1, 0, cA + kstep, vA); PG8_STB(1, 1, cB + kstep);
    PG8_WAIT_V(6); PG8_BAR;
    for (;;) {
        const bool has_next = S.next(ui + 1, nxt);
        const int nA = __builtin_amdgcn_readfirstlane(has_next ? S.a_off(nxt) : cA), nB = __builtin_amdgcn_readfirstlane(has_next ? S.b_off(nxt) : cB);
        if (GATHER) {
#pragma unroll
            for (int j = 0; j < 4; ++j) { const int pos = (j >> 1) * HALF + R0 + (j & 1) * 64; vAn[j] = has_next ? (unsigned)(S.arow(nxt, pos) * lda + C0 * 2) : vA[j]; }
        }
#pragma unroll 1
        for (int t = 0; t < nt; t += 2) {
            const bool last = (t == nt - 2);
            const int a1 = cA + (t + 1) * kstep;
            const int a2 = last ? nA : cA + (t + 2) * kstep, b2 = last ? nB : cB + (t + 2) * kstep;
            const int a3 = a2 + kstep, b3 = b2 + kstep;
            unsigned vX[4];
#pragma unroll
            for (int j = 0; j < 4; ++j) vX[j] = (GATHER && last) ? vAn[j] : vA[j];
            PG8_LDB(B0, 0, 0); PG8_LDB(B1, 0, 1); PG8_SCHED; PG8_LDA(At, 0, 0); PG8_STA(1, 1, a1, vA);
            PG8_WAIT_V(8); PG8_WAIT_L(0); PG8_BAR; PG8_MMA(0, 0, At, B0); PG8_MMA(0, 1, At, B1); PG8_BAR; PG8_SCHED;
            PG8_LDA(At, 0, 1); PG8_STB(0, 0, b2); PG8_STB(0, 1, b2); PG8_STA(0, 0, a2, vX);
            PG8_WAIT_V(8); PG8_WAIT_L(0); PG8_BAR; PG8_MMA(1, 0, At, B0); PG8_MMA(1, 1, At, B1); PG8_BAR; PG8_SCHED;
            PG8_LDB(B0, 1, 0); PG8_LDB(B1, 1, 1); PG8_SCHED; PG8_LDA(At, 1, 0); PG8_STA(0, 1, a2, vX);
            PG8_WAIT_V(8); PG8_WAIT_L(0); PG8_BAR; PG8_MMA(0, 0, At, B0); PG8_MMA(0, 1, At, B1); PG8_BAR; PG8_SCHED;
            PG8_LDA(At, 1, 1); PG8_STB(1, 0, b3); PG8_STB(1, 1, b3); PG8_STA(1, 0, a3, vX);
            PG8_WAIT_V(8); PG8_WAIT_L(0); PG8_BAR; PG8_MMA(1, 0, At, B0); PG8_MMA(1, 1, At, B1); PG8_BAR; PG8_SCHED;
        }
        if constexpr (ALIGN_EPI) { if (wr == 0) PG8_BAR; }
        if constexpr (FP8) asm volatile("s_nop 15\n\ts_nop 15\n\ts_nop 15" ::: "memory");
        { const int lane2 = __builtin_amdgcn_mbcnt_hi(~0u, __builtin_amdgcn_mbcnt_lo(~0u, 0u));
          int fr_ = lane2 & 15, fq_ = lane2 >> 4, wr_ = wr, wc_ = wc; asm volatile("" : "+v"(fr_), "+v"(fq_), "+s"(wr_), "+s"(wc_));
          E(acc, cur, wr_, wc_, fr_, fq_); }
        if (!has_next) break;
#pragma unroll
        for (int a = 0; a < 2; ++a)
#pragma unroll
            for (int b = 0; b < 2; ++b)
#pragma unroll
                for (int m = 0; m < 4; ++m)
#pragma unroll
                    for (int n = 0; n < 2; ++n) acc[a][b][m][n] = (f32x4){0.f, 0.f, 0.f, 0.f};
        cur = nxt; cA = nA; cB = nB; ++ui;
        if (GATHER) {
#pragma unroll
            for (int j = 0; j < 4; ++j) vA[j] = vAn[j];
        }
        if constexpr (ALIGN_EPI) { if (wr == 1) PG8_BAR; }
    }
    PG8_WAIT_V(0);
    if constexpr (!ALIGN_EPI) { if (wr == 0) PG8_BAR; }
    PG8_BAR;
#undef PG8_SA
#undef PG8_SB
#undef PG8_ST2
#undef PG8_STB
#undef PG8_STA
#undef PG8_LDA
#undef PG8_LDB
#undef PG8_MMA
#undef PG8_WAIT_V
#undef PG8_WAIT_L
#undef PG8_BAR
#undef PG8_SCHED
}

struct EpiBf16 {
    static constexpr bool PERM = true;
    bf16* O; int ldc;
    __device__ __forceinline__ void operator()(const f32x4 (&acc)[2][2][4][2], const Unit& u, int wr, int wc, int fr, int fq) const {
        const int row0 = u.pm * BM + wr * 64 + fr, col0 = u.pn * BM + wc * 32 + 8 * fq;
#pragma unroll
        for (int ai = 0; ai < 2; ++ai)
#pragma unroll
            for (int m = 0; m < 4; ++m) { bf16* rowp = O + (size_t)(row0 + ai * HALF + m * 16) * ldc + col0;
#pragma unroll
                for (int bj = 0; bj < 2; ++bj) { const f32x4 v0 = acc[ai][bj][m][0], v1 = acc[ai][bj][m][1];
                    u32x4 w; w.x = cvt_pk_bf16(v0[0], v0[1]); w.y = cvt_pk_bf16(v0[2], v0[3]); w.z = cvt_pk_bf16(v1[0], v1[1]); w.w = cvt_pk_bf16(v1[2], v1[3]);
                    *(u32x4*)(rowp + bj * HALF) = w; } }
    }
};
struct EpiRes {
    static constexpr bool PERM = true;
    bf16* C; const bf16* res; int ldc; float alpha;
    __device__ __forceinline__ void operator()(const f32x4 (&acc)[2][2][4][2], const Unit& u, int wr, int wc, int fr, int fq) const {
        const int row0 = u.pm * BM + wr * 64 + fr, col0 = u.pn * BM + wc * 32 + 8 * fq;
#pragma unroll
        for (int ai = 0; ai < 2; ++ai)
#pragma unroll
            for (int m = 0; m < 4; ++m) { const size_t off = (size_t)(row0 + ai * HALF + m * 16) * ldc + col0;
#pragma unroll
                for (int bj = 0; bj < 2; ++bj) { const u32x4 rr = *(const u32x4*)(res + off + bj * HALF); const f32x4 v0 = acc[ai][bj][m][0], v1 = acc[ai][bj][m][1];
                    u32x4 w; w.x = cvt_pk_bf16(v0[0] + alpha * bflo(rr.x), v0[1] + alpha * bfhi(rr.x)); w.y = cvt_pk_bf16(v0[2] + alpha * bflo(rr.y), v0[3] + alpha * bfhi(rr.y));
                    w.z = cvt_pk_bf16(v1[0] + alpha * bflo(rr.z), v1[1] + alpha * bfhi(rr.z)); w.w = cvt_pk_bf16(v1[2] + alpha * bflo(rr.w), v1[3] + alpha * bfhi(rr.w));
                    *(u32x4*)(C + off + bj * HALF) = w; } }
    }
};
struct EpiSlab {
    static constexpr bool PERM = false;
    float* C; int ldc; size_t slab;
    __device__ __forceinline__ void operator()(const f32x4 (&acc)[2][2][4][2], const Unit& u, int wr, int wc, int fr, int fq) const {
        const int row0 = u.pm * BM + wr * 64 + fr, col0 = u.pn * BM + wc * 32 + 4 * fq; float* base = C + (size_t)u.e * slab;
#pragma unroll
        for (int ai = 0; ai < 2; ++ai)
#pragma unroll
            for (int m = 0; m < 4; ++m) { float* rowp = base + (size_t)(row0 + ai * HALF + m * 16) * ldc + col0;
#pragma unroll
                for (int bj = 0; bj < 2; ++bj)
#pragma unroll
                    for (int n = 0; n < 2; ++n) *(f32x4*)(rowp + bj * HALF + n * 16) = acc[ai][bj][m][n]; }
    }
};
}

struct Params {
    const float *x, *mem, *ln_in_g, *ln_in_b, *w_in, *b_f, *fq_g, *fk_g, *mix_g, *w_out, *ln_mix_g, *ln_mix_b, *mem_ln_g, *mem_ln_b,
                *xa_wq, *xa_wkv, *xa_wo, *ln_xa_g, *ln_xa_b, *router_w, *router_b, *w_up, *b_up, *w_down, *b_down, *ln_moe_g, *ln_moe_b;
    float* out; unsigned char* ws; int ph_lo, ph_hi;
};
#define CAS __attribute__((address_space(4)))
typedef const CAS Params* PP;
#define P_FRESH(pq) asm volatile("" : "+s"(pq))
struct Frame {
    LAS unsigned char* lds; volatile LAS unsigned* MISC; gu32* ctl;
    int tid, lane, wave, vcu, G;
    __device__ __forceinline__ void fresh() { int t = threadIdx.x; asm volatile("" : "+v"(t)); tid = t; lane = t & 63; wave = __builtin_amdgcn_readfirstlane(t >> 6); }
};

__device__ __forceinline__ void tr_item(const float* W, int ldw, int k0, int scol, bf16* WT, int ldk, int drow, LAS float* scr, int lane) {
#pragma unroll 8
    for (int i = 0; i < 32; ++i) { const int kk = 2 * i + (lane >> 5); scr[kk * 33 + (lane & 31)] = W[(size_t)(k0 + kk) * ldw + scol + (lane & 31)]; }
    LDS_WAIT(); asm volatile("" ::: "memory");
    const int c = lane & 7;
#pragma unroll
    for (int j = 0; j < 4; ++j) { const int n = (lane >> 3) + 8 * j; const LAS float* s = scr + (8 * c) * 33 + n;
        u32x4 o; o.x = pk2(s[0 * 33], s[1 * 33]); o.y = pk2(s[2 * 33], s[3 * 33]); o.z = pk2(s[4 * 33], s[5 * 33]); o.w = pk2(s[6 * 33], s[7 * 33]);
        *(GAS u32x4*)(WT + (size_t)(drow + n) * ldk + k0 + 8 * c) = o; }
    LDS_WAIT(); asm volatile("" ::: "memory");
}
constexpr int TR_RS = 192, TR_WAVE_BYTES = 64 * TR_RS;
__device__ __forceinline__ void tr64_load(f32x4 (&v)[16], const float* W, int ldw, int k0, int scol, int lane) {
    const float* src = W + (size_t)(k0 + (lane >> 4)) * ldw + scol + 4 * (lane & 15);
#pragma unroll
    for (int i = 0; i < 16; ++i) v[i] = *(const GAS f32x4*)(src + (size_t)(4 * i) * ldw);
}
__device__ __forceinline__ void tr64_finish(const f32x4 (&v)[16], bf16* WT, int ldk, int k0, int drow, LAS unsigned char* scr, int lane) {
#pragma unroll
    for (int i = 0; i < 16; ++i) { const int k = 4 * i + (lane >> 4); *(LAS u32x2*)(scr + k * TR_RS + 8 * (lane & 15)) = (u32x2){cvt_pk_bf16(v[i][0], v[i][1]), cvt_pk_bf16(v[i][2], v[i][3])}; }
    LDS_WAIT(); asm volatile("" ::: "memory");
    const int G = lane >> 4, i16 = lane & 15, q = i16 >> 2, pp = i16 & 3;
#pragma unroll
    for (int nb = 0; nb < 4; ++nb)
#pragma unroll
        for (int s2 = 0; s2 < 2; ++s2) { const int c = 4 * s2 + G;
            LAS unsigned char* a = scr + (8 * c + q) * TR_RS + (16 * nb + 4 * pp) * 2;
            const s16x4 lo = __builtin_bit_cast(s16x4, __builtin_amdgcn_ds_read_tr16_b64_v4i16((LAS v4i16_t*)a));
            const s16x4 hh = __builtin_bit_cast(s16x4, __builtin_amdgcn_ds_read_tr16_b64_v4i16((LAS v4i16_t*)(a + 4 * TR_RS)));
            const bf16x8 o = {lo[0], lo[1], lo[2], lo[3], hh[0], hh[1], hh[2], hh[3]};
            *(GAS bf16x8*)(WT + (size_t)(drow + 16 * nb + i16) * ldk + k0 + 8 * c) = o; }
    LDS_WAIT(); asm volatile("" ::: "memory");
}
__device__ __forceinline__ void tr64_finish_fp8(const f32x4 (&v)[16], unsigned char* WT, int ldk, int k0, int drow, LAS unsigned char* scr, int lane) {
#pragma unroll
    for (int i = 0; i < 16; ++i) { const int k = 4 * i + (lane >> 4); *(LAS u32x2*)(scr + k * TR_RS + 8 * (lane & 15)) = (u32x2){cvt_pk_bf16(v[i][0], v[i][1]), cvt_pk_bf16(v[i][2], v[i][3])}; }
    LDS_WAIT(); asm volatile("" ::: "memory");
    const int G = lane >> 4, i16 = lane & 15, q = i16 >> 2, pp = i16 & 3;
#pragma unroll
    for (int nb = 0; nb < 4; ++nb) { LAS unsigned char* a = scr + (16 * G + q) * TR_RS + (16 * nb + 4 * pp) * 2; unsigned w[4];
#pragma unroll
        for (int t = 0; t < 4; ++t) { const s16x4 x = __builtin_bit_cast(s16x4, __builtin_amdgcn_ds_read_tr16_b64_v4i16((LAS v4i16_t*)(a + 4 * t * TR_RS)));
            w[t] = pk4_fp8(bf2f((unsigned short)x[0]) * F8S_W, bf2f((unsigned short)x[1]) * F8S_W, bf2f((unsigned short)x[2]) * F8S_W, bf2f((unsigned short)x[3]) * F8S_W); }
        *(GAS u32x4*)(WT + (size_t)(drow + 16 * nb + i16) * ldk + k0 + 16 * G) = (u32x4){w[0], w[1], w[2], w[3]}; }
    LDS_WAIT(); asm volatile("" ::: "memory");
}
__device__ __forceinline__ void ln_row_store(f32x4 (&v)[16], const float* g, const float* b, bf16* orow, float* orow32, int lane, unsigned char* orow8 = nullptr) {
    float s = 0.f;
#pragma unroll
    for (int j = 0; j < 16; ++j) s += (v[j].x + v[j].y) + (v[j].z + v[j].w);
    const float mean = wave_sum(s) * (1.f / DM); float s2 = 0.f;
#pragma unroll
    for (int j = 0; j < 16; ++j) { v[j] = v[j] - mean; s2 += (v[j].x * v[j].x + v[j].y * v[j].y) + (v[j].z * v[j].z + v[j].w * v[j].w); }
    const float rstd = 1.f / sqrtf(wave_sum(s2) * (1.f / DM) + LN_EPS);
    const GAS f32x4* g4 = (const GAS f32x4*)g + lane; const GAS f32x4* b4 = (const GAS f32x4*)b + lane;
#pragma unroll
    for (int j = 0; j < 16; ++j) { const f32x4 gg = g4[64 * j], bb = b4[64 * j]; const f32x4 y = v[j] * rstd * gg + bb;
        if (orow) ((GAS u32x2*)orow)[lane + 64 * j] = (u32x2){pk2(y.x, y.y), pk2(y.z, y.w)};
        if (orow32) ((GAS f32x4*)orow32)[lane + 64 * j] = y;
        if (orow8) ((GAS unsigned*)orow8)[lane + 64 * j] = pk4_fp8(y.x * F8S_H2, y.y * F8S_H2, y.z * F8S_H2, y.w * F8S_H2); }
}
__device__ __forceinline__ void ln_row_f32(const float* xrow, const float* g, const float* b, bf16* orow, int lane) {
    f32x4 v[16];
#pragma unroll
    for (int j = 0; j < 16; ++j) v[j] = ((const GAS f32x4*)xrow)[lane + 64 * j];
    ln_row_store(v, g, b, orow, nullptr, lane);
}

__device__ __forceinline__ void ln_rows_f32(const float* X, const float* g, const float* b, bf16* O, int m0, int stride, int mend, int lane, unsigned char* O8 = nullptr) {
    f32x4 nx[16]; int m = m0;
    if (m < mend) {
#pragma unroll
        for (int j = 0; j < 16; ++j) nx[j] = ((const GAS f32x4*)(X + (size_t)m * DM))[lane + 64 * j]; }
    while (m < mend) {
        f32x4 v[16];
#pragma unroll
        for (int j = 0; j < 16; ++j) v[j] = nx[j];
        const int mc = m; m += stride;
        if (m < mend) {
#pragma unroll
            for (int j = 0; j < 16; ++j) nx[j] = ((const GAS f32x4*)(X + (size_t)m * DM))[lane + 64 * j]; }
        ln_row_store(v, g, b, O + (size_t)mc * DM, nullptr, lane, O8 ? O8 + (size_t)mc * DM : nullptr);
    }
}

__device__ __forceinline__ void ln_rows_bf16(const bf16* X, const float* g, const float* b, bf16* O, int m0, int stride, int mend, int lane, unsigned char* O8 = nullptr) {
    u32x2 nx[16]; int m = m0;
    if (m < mend) {
#pragma unroll
        for (int j = 0; j < 16; ++j) nx[j] = ((const GAS u32x2*)(X + (size_t)m * DM))[lane + 64 * j]; }
    while (m < mend) {
        f32x4 v[16];
#pragma unroll
        for (int j = 0; j < 16; ++j) v[j] = (f32x4){bflo(nx[j].x), bfhi(nx[j].x), bflo(nx[j].y), bfhi(nx[j].y)};
        const int mc = m; m += stride;
        if (m < mend) {
#pragma unroll
            for (int j = 0; j < 16; ++j) nx[j] = ((const GAS u32x2*)(X + (size_t)m * DM))[lane + 64 * j]; }
        ln_row_store(v, g, b, O + (size_t)mc * DM, nullptr, lane, O8 ? O8 + (size_t)mc * DM : nullptr);
    }
}

constexpr int SHM_KV = 64 * HD * 2;
#define KSWZ(row, colB) ((row) * 256 + ((colB) ^ (((row) & 7) << 4)))
__device__ __forceinline__ int v_st(int k, int c) { const int kk = (k & ~0xC) | ((k & 4) << 1) | ((k & 8) >> 1); return ((kk >> 3) * 4 + (c >> 5)) * 512 + ((kk & 7) * 32 + (c & 31)) * 2; }
__device__ __forceinline__ int v_rd_base(int lane) { return ((lane & 3) << 3) | (((lane >> 2) & 3) << 6) | (((lane >> 4) & 1) << 5) | (((lane >> 5) & 1) << 8); }
constexpr int v_rd_off(int d0, int ks, int half) { return d0 * 512 + ks * 4096 + half * 2048; }
__device__ __forceinline__ int crow(int r, int hi) { return (r & 3) + 8 * (r >> 2) + 4 * hi; }
__device__ __forceinline__ bf16x8 pack8(f32x4 a, f32x4 b) { u32x4 w = {cvt_pk_bf16(a[0], a[1]), cvt_pk_bf16(a[2], a[3]), cvt_pk_bf16(b[0], b[1]), cvt_pk_bf16(b[2], b[3])}; return __builtin_bit_cast(bf16x8, w); }
__device__ __forceinline__ void qkt(f32x16& p0, f32x16& p1, LAS const unsigned char* Kt, int r32, int hi, const bf16x8* qr) {
    p0 = f32x16{}; p1 = f32x16{};
    LAS const unsigned char* kb[4];
#pragma unroll
    for (int dd = 0; dd < 4; ++dd) kb[dd] = Kt + KSWZ(r32, (dd * 16 + hi * 8) * 2);
#pragma unroll
    for (int d0 = 0; d0 < 8; ++d0) { LAS const unsigned char* a = kb[d0 & 3] + (d0 >> 2) * 128;
        const bf16x8 b0 = *(LAS const bf16x8*)a; const bf16x8 b1 = *(LAS const bf16x8*)(a + 32 * 256);
        p0 = __builtin_amdgcn_mfma_f32_32x32x16_bf16(b0, qr[d0], p0, 0, 0, 0);
        p1 = __builtin_amdgcn_mfma_f32_32x32x16_bf16(b1, qr[d0], p1, 0, 0, 0); }
}
__device__ __forceinline__ void pack_p(const f32x16& p0, const f32x16& p1, bf16x8& pa0, bf16x8& pa1, bf16x8& pa2, bf16x8& pa3) {
#define PK4(P, B_, OUT) do { unsigned a0 = cvt_pk_bf16(P[B_+0], P[B_+1]), a1 = cvt_pk_bf16(P[B_+2], P[B_+3]); \
        unsigned b0 = cvt_pk_bf16(P[B_+4], P[B_+5]), b1 = cvt_pk_bf16(P[B_+6], P[B_+7]); \
        auto r0 = __builtin_amdgcn_permlane32_swap(a0, b0, false, false); auto r1 = __builtin_amdgcn_permlane32_swap(a1, b1, false, false); \
        u32x4 w = {r0[0], r1[0], r0[1], r1[1]}; OUT = __builtin_bit_cast(bf16x8, w); } while (0)
    PK4(p0, 0, pa0); PK4(p0, 8, pa1); PK4(p1, 0, pa2); PK4(p1, 8, pa3);
#undef PK4
}
__device__ __forceinline__ void pv_tile(f32x16* o, int vb0, bf16x8 pa0, bf16x8 pa1, bf16x8 pa2, bf16x8 pa3) {
#define TRRD(dst, off) asm volatile("ds_read_b64_tr_b16 %0, %1 offset:%2" : "=&v"(dst) : "v"(vb0), "i"(off) : "memory")
#define PV_D0(d0) do { s16x4 l0, l1, l2, l3, h0, h1, h2, h3; constexpr int b_ = v_rd_off(d0, 0, 0); \
        TRRD(l0, b_); TRRD(h0, b_ + 2048); TRRD(l1, b_ + 4096); TRRD(h1, b_ + 6144); TRRD(l2, b_ + 8192); TRRD(h2, b_ + 10240); TRRD(l3, b_ + 12288); TRRD(h3, b_ + 14336); \
        asm volatile("s_waitcnt lgkmcnt(0)" ::: "memory"); SBAR(); \
        o[d0] = __builtin_amdgcn_mfma_f32_32x32x16_bf16(pa0, (bf16x8){l0[0], l0[1], l0[2], l0[3], h0[0], h0[1], h0[2], h0[3]}, o[d0], 0, 0, 0); \
        o[d0] = __builtin_amdgcn_mfma_f32_32x32x16_bf16(pa1, (bf16x8){l1[0], l1[1], l1[2], l1[3], h1[0], h1[1], h1[2], h1[3]}, o[d0], 0, 0, 0); \
        o[d0] = __builtin_amdgcn_mfma_f32_32x32x16_bf16(pa2, (bf16x8){l2[0], l2[1], l2[2], l2[3], h2[0], h2[1], h2[2], h2[3]}, o[d0], 0, 0, 0); \
        o[d0] = __builtin_amdgcn_mfma_f32_32x32x16_bf16(pa3, (bf16x8){l3[0], l3[1], l3[2], l3[3], h3[0], h3[1], h3[2], h3[3]}, o[d0], 0, 0, 0); } while (0)
    PV_D0(0); PV_D0(1); PV_D0(2); PV_D0(3);
#undef PV_D0
#undef TRRD
}

__device__ __forceinline__ void pack_half(const f32x16& p, bf16x8& pa, bf16x8& pb) {
#define PK4(P, B_, OUT) do { unsigned a0 = cvt_pk_bf16(P[B_+0], P[B_+1]), a1 = cvt_pk_bf16(P[B_+2], P[B_+3]); \
        unsigned b0 = cvt_pk_bf16(P[B_+4], P[B_+5]), b1 = cvt_pk_bf16(P[B_+6], P[B_+7]); \
        auto r0 = __builtin_amdgcn_permlane32_swap(a0, b0, false, false); auto r1 = __builtin_amdgcn_permlane32_swap(a1, b1, false, false); \
        u32x4 w = {r0[0], r1[0], r0[1], r1[1]}; OUT = __builtin_bit_cast(bf16x8, w); } while (0)
    PK4(p, 0, pa); PK4(p, 8, pb);
#undef PK4
}
template <int KS0>
__device__ __forceinline__ void pv_half(f32x16* o, int vb0, bf16x8 pa, bf16x8 pb) {
#define TRRD(dst, off) asm volatile("ds_read_b64_tr_b16 %0, %1 offset:%2" : "=&v"(dst) : "v"(vb0), "i"(off) : "memory")
#define PV_D0(d0) do { s16x4 l0, l1, h0, h1; constexpr int b_ = v_rd_off(d0, KS0, 0); \
        TRRD(l0, b_); TRRD(h0, b_ + 2048); TRRD(l1, b_ + 4096); TRRD(h1, b_ + 6144); \
        asm volatile("s_waitcnt lgkmcnt(0)" ::: "memory"); SBAR(); \
        o[d0] = __builtin_amdgcn_mfma_f32_32x32x16_bf16(pa, (bf16x8){l0[0], l0[1], l0[2], l0[3], h0[0], h0[1], h0[2], h0[3]}, o[d0], 0, 0, 0); \
        o[d0] = __builtin_amdgcn_mfma_f32_32x32x16_bf16(pb, (bf16x8){l1[0], l1[1], l1[2], l1[3], h1[0], h1[1], h1[2], h1[3]}, o[d0], 0, 0, 0); } while (0)
    PV_D0(0); PV_D0(1); PV_D0(2); PV_D0(3);
#undef PV_D0
#undef TRRD
}
constexpr int AT_K = 0, AT_V = 2 * SHM_KV, AT_C2 = 4 * SHM_KV, AT_RK = AT_C2 + 8192, AT_WS = AT_RK + 8192, AT_OST = AT_WS + 2048, OST_WAVE = 32 * 33 * 4, AT_END = AT_OST + 8 * OST_WAVE;
static_assert(AT_END <= RING_BYTES, "attention LDS map");

__device__ __forceinline__ void o_rows(const f32x16* o, const float (&il)[16], LAS float* ost, int lane, float (&v)[4][16], float& ss) {
    const int r32 = lane & 31, hi = lane >> 5, row = lane >> 1, half = lane & 1; ss = 0.f;
#pragma unroll
    for (int d0 = 0; d0 < 4; ++d0) {
#pragma unroll
        for (int r = 0; r < 16; ++r) ost[crow(r, hi) * 33 + r32] = o[d0][r] * il[r];
        LDS_WAIT(); asm volatile("" ::: "memory");
#pragma unroll
        for (int i = 0; i < 16; ++i) { v[d0][i] = ost[row * 33 + 16 * half + i]; }
        LDS_WAIT(); asm volatile("" ::: "memory");
#pragma unroll
        for (int i = 0; i < 16; ++i) ss += v[d0][i] * v[d0][i];
    }
}
__device__ __forceinline__ void store16_bf16(bf16* dst, const float (&y)[16]) {
    u32x4 w0 = {cvt_pk_bf16(y[0], y[1]), cvt_pk_bf16(y[2], y[3]), cvt_pk_bf16(y[4], y[5]), cvt_pk_bf16(y[6], y[7])};
    u32x4 w1 = {cvt_pk_bf16(y[8], y[9]), cvt_pk_bf16(y[10], y[11]), cvt_pk_bf16(y[12], y[13]), cvt_pk_bf16(y[14], y[15])};
    *(GAS u32x4*)dst = w0; *(GAS u32x4*)(dst + 8) = w1;
}
__device__ __forceinline__ void fox_tables(Frame F, PP p, int b, int h) {
    F.fresh();
    LAS float* c2t = (LAS float*)(F.lds + AT_C2); LAS float* rkt = (LAS float*)(F.lds + AT_RK); LAS float* red = (LAS float*)(F.lds + AT_WS);
    const float* FL = (const float*)(p->ws + WS_FL); const float bfh = p->b_f[h];
    __syncthreads();
    float v[4], run = 0.f;
#pragma unroll
    for (int i = 0; i < 4; ++i) { const float x = FL[(size_t)(b * SEQ + 4 * F.tid + i) * 16 + h] + bfh; const float y = -x * LOG2E;
        const float sp = fmaxf(y, 0.f) + __builtin_amdgcn_logf(1.f + __builtin_amdgcn_exp2f(-fabsf(y))); run -= sp; v[i] = run; }
    float incl = run;
#pragma unroll
    for (int o = 1; o < 64; o <<= 1) { const float t = __shfl_up(incl, o); if (F.lane >= o) incl += t; }
    if (F.lane == 63) red[F.wave] = incl;
    __syncthreads();
    float woff = 0.f;
    for (int w = 0; w < F.wave; ++w) woff += red[w];
    const float base = woff + incl - run;
#pragma unroll
    for (int i = 0; i < 4; ++i) c2t[4 * F.tid + i] = v[i] + base;
    const bf16* Kg = (const bf16*)(p->ws + WS_P) + (size_t)(b * SEQ) * NP + PC_KF + h * HD + (F.lane & 15) * 8;
#pragma unroll 8
    for (int it = 0; it < 64; ++it) { const int s = F.wave * 256 + it * 4 + (F.lane >> 4);
        const u32x4 w = *(const GAS u32x4*)(Kg + (size_t)s * NP);
        float ss = bflo(w.x) * bflo(w.x) + bfhi(w.x) * bfhi(w.x) + bflo(w.y) * bflo(w.y) + bfhi(w.y) * bfhi(w.y) + bflo(w.z) * bflo(w.z) + bfhi(w.z) * bfhi(w.z) + bflo(w.w) * bflo(w.w) + bfhi(w.w) * bfhi(w.w);
        ss += __shfl_xor(ss, 1); ss += __shfl_xor(ss, 2); ss += __shfl_xor(ss, 4); ss += __shfl_xor(ss, 8);
        if ((F.lane & 15) == 0) rkt[s] = 1.f / sqrtf(ss * (1.f / HD) + RMS_EPS); }
    __syncthreads();
}

template <int MODE>
__device__ __forceinline__ void attn_unit(Frame F, PP p, int b, int h, int qb) {
    F.fresh();
    const int lane = F.lane, wave = F.wave, r32 = lane & 31, hi = lane >> 5;
    const bf16* Pg = (const bf16*)(p->ws + WS_P) + (size_t)(b * SEQ) * NP;
    const int cq = (MODE == 0 ? PC_QF : PC_QS) + h * HD, ck = (MODE == 0 ? PC_KF : PC_KS) + h * HD, cv = (MODE == 0 ? PC_VF : PC_VS) + h * HD;
    LAS const float* c2t = (LAS const float*)(F.lds + AT_C2); LAS const float* rkt = (LAS const float*)(F.lds + AT_RK);
    const int trow = 256 * qb + 32 * wave;
    const int jd = 4 * qb + (wave >> 1), lam = 32 * (wave & 1) + r32, NT = 4 * qb + 4;
    unsigned dk[2], dv[2];
#pragma unroll
    for (int i = 0; i < 2; ++i) { const int q = (wave * 2 + i) * 1024 + lane * 16;
        { const int row = q >> 8, cb = (q & 255) ^ ((row & 7) << 4); dk[i] = (unsigned)(row * NP + ck + (cb >> 1)); }
        { const int st = q >> 9, inner = (q & 511) >> 1, kk = (st >> 2) * 8 + (inner >> 5), c = (st & 3) * 32 + (inner & 31); const int k = (kk & ~0xC) | ((kk & 4) << 1) | ((kk & 8) >> 1);
          dv[i] = (unsigned)(k * NP + cv + c); } }
#define AT_DMA(j, bf) do { const bf16* tb_ = Pg + (size_t)(64 * (j)) * NP; LAS unsigned char* kd_ = F.lds + AT_K + (bf) * SHM_KV + wave * 2048; LAS unsigned char* vd_ = F.lds + AT_V + (bf) * SHM_KV + wave * 2048; \
        __builtin_amdgcn_global_load_lds((const unsigned*)(tb_ + dk[0]), (LAS unsigned*)kd_, 16, 0, 0); __builtin_amdgcn_global_load_lds((const unsigned*)(tb_ + dk[1]), (LAS unsigned*)(kd_ + 1024), 16, 0, 0); \
        __builtin_amdgcn_global_load_lds((const unsigned*)(tb_ + dv[0]), (LAS unsigned*)vd_, 16, 0, 0); __builtin_amdgcn_global_load_lds((const unsigned*)(tb_ + dv[1]), (LAS unsigned*)(vd_ + 1024), 16, 0, 0); } while (0)
    __syncthreads();
    AT_DMA(MODE == 0 ? 0 : NT - 1, 0);
    bf16x8 qr[8];
    { const bf16* qp = Pg + (size_t)(trow + r32) * NP + cq + hi * 8;
      u32x4 raw[8];
#pragma unroll
      for (int d0 = 0; d0 < 8; ++d0) raw[d0] = *(const GAS u32x4*)(qp + 16 * d0);
      float sc_q = C2;
      if (MODE == 0) { float ss = 0.f;
#pragma unroll
          for (int d0 = 0; d0 < 8; ++d0) { const u32x4 w = raw[d0]; ss += bflo(w.x) * bflo(w.x) + bfhi(w.x) * bfhi(w.x) + bflo(w.y) * bflo(w.y) + bfhi(w.y) * bfhi(w.y) + bflo(w.z) * bflo(w.z) + bfhi(w.z) * bfhi(w.z) + bflo(w.w) * bflo(w.w) + bfhi(w.w) * bfhi(w.w); }
          ss += __shfl_xor(ss, 32); sc_q = C2 / sqrtf(ss * (1.f / HD) + RMS_EPS); }
#pragma unroll
      for (int d0 = 0; d0 < 8; ++d0) { const u32x4 w = raw[d0]; f32x4 a = {bflo(w.x), bfhi(w.x), bflo(w.y), bfhi(w.y)}, c = {bflo(w.z), bfhi(w.z), bflo(w.w), bfhi(w.w)};
          if (MODE == 0) { const GAS f32x4* gq = (const GAS f32x4*)(p->fq_g + 16 * d0 + 8 * hi); const GAS f32x4* gk = (const GAS f32x4*)(p->fk_g + 16 * d0 + 8 * hi);
              a = a * (gq[0] * gk[0]); c = c * (gq[1] * gk[1]); asm volatile("" ::: "memory"); }
          qr[d0] = pack8(a * sc_q, c * sc_q); } }
    f32x16 o[4] = {};
    float lsum = 0.f;
    const float ref = (MODE == 0) ? c2t[trow + 31] : 0.f;
    bf16x8 Atri0, Atri1, Aone; f32x16 carry = {};
    if (MODE == 1) {
#pragma unroll
        for (int j = 0; j < 8; ++j) { const int k0 = 8 * (j >> 2) + 4 * hi + (j & 3); Atri0[j] = (k0 > r32) ? (short)0xBF80 : (short)0; Atri1[j] = (16 + k0 > r32) ? (short)0xBF80 : (short)0; Aone[j] = (short)0xBF80; }
    }
    const int koff = KSWZ(r32, hi * 16), vroff = v_rd_base(lane);
    for (int it = 0; it < NT; ++it) {
        const int j = (MODE == 0) ? it : NT - 1 - it; const int bf = it & 1;
        asm volatile("s_waitcnt vmcnt(0)" ::: "memory");
        __syncthreads();
        if (it + 1 < NT) AT_DMA(MODE == 0 ? it + 1 : NT - 2 - it, bf ^ 1);
        if (j <= jd) {
            LAS const unsigned char* Kt = F.lds + AT_K + bf * SHM_KV; const int vb0 = (int)(uintptr_t)(F.lds + AT_V + bf * SHM_KV) + vroff;
            f32x16 p0 = {}, p1 = {};
#pragma unroll
            for (int d0 = 0; d0 < 8; ++d0) { const bf16x8 b0 = *(LAS const bf16x8*)(Kt + (koff ^ ((d0 & 3) << 5)) + (d0 >> 2) * 128); p0 = __builtin_amdgcn_mfma_f32_32x32x16_bf16(b0, qr[d0], p0, 0, 0, 0); }
#pragma unroll
            for (int d0 = 0; d0 < 8; ++d0) { const bf16x8 b1 = *(LAS const bf16x8*)(Kt + (koff ^ ((d0 & 3) << 5)) + (d0 >> 2) * 128 + 32 * 256); p1 = __builtin_amdgcn_mfma_f32_32x32x16_bf16(b1, qr[d0], p1, 0, 0, 0); }
            bf16x8 pa0, pa1, pa2, pa3;
            if (MODE == 0) {
#pragma unroll
                for (int g = 0; g < 4; ++g) { const f32x4 rk0 = *(LAS const f32x4*)(rkt + 64 * j + 8 * g + 4 * hi), cc0 = *(LAS const f32x4*)(c2t + 64 * j + 8 * g + 4 * hi);
#pragma unroll
                    for (int i = 0; i < 4; ++i) p0[4 * g + i] = fmaf(p0[4 * g + i], rk0[i], ref - cc0[i]); }
                if (j == jd) { int lam2 = lam - 4 * hi; asm volatile("" : "+v"(lam2));
#pragma unroll
                    for (int r = 0; r < 16; ++r) { const int kap = (r & 3) + 8 * (r >> 2); if (kap > lam2) p0[r] = -__builtin_inff(); } }
#pragma unroll
                for (int r = 0; r < 16; ++r) { p0[r] = __builtin_amdgcn_exp2f(p0[r]); lsum += p0[r]; }
                pack_half(p0, pa0, pa1);
                pv_half<0>(o, vb0, pa0, pa1);
#pragma unroll
                for (int g = 0; g < 4; ++g) { const f32x4 rk1 = *(LAS const f32x4*)(rkt + 64 * j + 32 + 8 * g + 4 * hi), cc1 = *(LAS const f32x4*)(c2t + 64 * j + 32 + 8 * g + 4 * hi);
#pragma unroll
                    for (int i = 0; i < 4; ++i) p1[4 * g + i] = fmaf(p1[4 * g + i], rk1[i], ref - cc1[i]); }
                if (j == jd) { int lam2 = lam - 4 * hi; asm volatile("" : "+v"(lam2));
#pragma unroll
                    for (int r = 0; r < 16; ++r) { const int kap = (r & 3) + 8 * (r >> 2); if (kap + 32 > lam2) p1[r] = -__builtin_inff(); } }
#pragma unroll
                for (int r = 0; r < 16; ++r) { p1[r] = __builtin_amdgcn_exp2f(p1[r]); lsum += p1[r]; }
                pack_half(p1, pa2, pa3);
                pv_half<2>(o, vb0, pa2, pa3);
            } else {
                f32x16 s0, s1;
#pragma unroll
                for (int r = 0; r < 16; ++r) s0[r] = __builtin_amdgcn_logf(1.f + __builtin_amdgcn_exp2f(p0[r]));
                if (j == jd) { int lam2 = lam - 4 * hi; asm volatile("" : "+v"(lam2));
#pragma unroll
                    for (int r = 0; r < 16; ++r) { const int kap = (r & 3) + 8 * (r >> 2); if (kap >= lam2) s0[r] = 0.f; } }
#pragma unroll
                for (int r = 0; r < 16; ++r) p0[r] -= s0[r];
                const float s00 = s0[0];
                const bf16x8 bs0 = pack8((f32x4){s0[0], s0[1], s0[2], s0[3]}, (f32x4){s0[4], s0[5], s0[6], s0[7]}), bs1 = pack8((f32x4){s0[8], s0[9], s0[10], s0[11]}, (f32x4){s0[12], s0[13], s0[14], s0[15]});
#pragma unroll
                for (int r = 0; r < 16; ++r) s1[r] = __builtin_amdgcn_logf(1.f + __builtin_amdgcn_exp2f(p1[r]));
                if (j == jd) { int lam2 = lam - 4 * hi; asm volatile("" : "+v"(lam2));
#pragma unroll
                    for (int r = 0; r < 16; ++r) { const int kap = (r & 3) + 8 * (r >> 2); if (kap + 32 >= lam2) s1[r] = 0.f; } }
#pragma unroll
                for (int r = 0; r < 16; ++r) p1[r] -= s1[r];
                const bf16x8 bs2 = pack8((f32x4){s1[0], s1[1], s1[2], s1[3]}, (f32x4){s1[4], s1[5], s1[6], s1[7]}), bs3 = pack8((f32x4){s1[8], s1[9], s1[10], s1[11]}, (f32x4){s1[12], s1[13], s1[14], s1[15]});
                f32x16 t1 = __builtin_amdgcn_mfma_f32_32x32x16_bf16(Atri0, bs2, carry, 0, 0, 0);
                t1 = __builtin_amdgcn_mfma_f32_32x32x16_bf16(Atri1, bs3, t1, 0, 0, 0);
                f32x16 t0 = __builtin_amdgcn_mfma_f32_32x32x16_bf16(Atri0, bs0, carry, 0, 0, 0);
                t0 = __builtin_amdgcn_mfma_f32_32x32x16_bf16(Atri1, bs1, t0, 0, 0, 0);
                t0 = __builtin_amdgcn_mfma_f32_32x32x16_bf16(Aone, bs2, t0, 0, 0, 0);
                t0 = __builtin_amdgcn_mfma_f32_32x32x16_bf16(Aone, bs3, t0, 0, 0, 0);
#pragma unroll
                for (int r = 0; r < 16; ++r) p1[r] = __builtin_amdgcn_exp2f(p1[r] + t1[r]);
                if (j == jd) { int lam2 = lam - 4 * hi; asm volatile("" : "+v"(lam2));
#pragma unroll
                    for (int r = 0; r < 16; ++r) { const int kap = (r & 3) + 8 * (r >> 2); if (kap + 32 >= lam2) p1[r] = 0.f; } }
                pack_half(p1, pa2, pa3);
                pv_half<2>(o, vb0, pa2, pa3);
                { const float cv_ = t0[0] - s00; auto rr = __builtin_amdgcn_permlane32_swap(__float_as_uint(cv_), __float_as_uint(cv_), false, false); const float cn = __uint_as_float(rr[0]);
#pragma unroll
                  for (int r = 0; r < 16; ++r) carry[r] = cn; }
#pragma unroll
                for (int r = 0; r < 16; ++r) p0[r] = __builtin_amdgcn_exp2f(p0[r] + t0[r]);
                if (j == jd) { int lam2 = lam - 4 * hi; asm volatile("" : "+v"(lam2));
#pragma unroll
                    for (int r = 0; r < 16; ++r) { const int kap = (r & 3) + 8 * (r >> 2); if (kap >= lam2) p0[r] = 0.f; } }
                pack_half(p0, pa0, pa1);
                pv_half<0>(o, vb0, pa0, pa1);
            }
        }
    }
#undef AT_DMA
    int b2 = b, h2 = h, qb2 = qb;
    asm volatile("" : "+s"(b2), "+s"(h2), "+s"(qb2));
    P_FRESH(p);
    LAS float* wsw = (LAS float*)(F.lds + AT_WS) + 64 + wave * 48; LAS float* ost = (LAS float*)(F.lds + AT_OST + wave * OST_WAVE);
    float il[16];
    if (MODE == 0) { lsum += __shfl_xor(lsum, 32); if (hi == 0) wsw[r32] = 1.f / lsum; LDS_WAIT(); asm volatile("" ::: "memory");
#pragma unroll
        for (int r = 0; r < 16; ++r) il[r] = wsw[crow(r, hi)]; }
    else {
#pragma unroll
        for (int r = 0; r < 16; ++r) il[r] = 1.f; }
    float v[4][16], ss;
    o_rows(o, il, ost, lane, v, ss);
    ss += __shfl_xor(ss, 1);
    const float rstd = 1.f / sqrtf(ss * (1.f / HD) + RMS_EPS);
    const int row = lane >> 1, half = lane & 1; const size_t srow = (size_t)b2 * SEQ + 256 * qb2 + 32 * wave + row;
    const float* mg = p->mix_g + (MODE == 0 ? h2 : NFH + h2) * HD + 16 * half;
    bf16* Og = (bf16*)(p->ws + WS_O) + srow * DM + (MODE == 0 ? 0 : NFH * HD) + h2 * HD + 16 * half;
    const bf16* Gg = (const bf16*)(p->ws + WS_P) + srow * NP + PC_GF + h2 * HD + 16 * half;
#pragma unroll
    for (int d0 = 0; d0 < 4; ++d0) { float y[16];
#pragma unroll
        for (int q4 = 0; q4 < 4; ++q4) { const f32x4 g4 = *(const GAS f32x4*)(mg + 32 * d0 + 4 * q4);
#pragma unroll
            for (int i = 0; i < 4; ++i) y[4 * q4 + i] = v[d0][4 * q4 + i] * rstd * g4[i]; }
        if (MODE == 0) { const u32x4 ga = *(const GAS u32x4*)(Gg + 32 * d0), gb = *(const GAS u32x4*)(Gg + 32 * d0 + 8);
            const unsigned gw[8] = {ga.x, ga.y, ga.z, ga.w, gb.x, gb.y, gb.z, gb.w};
#pragma unroll
            for (int i = 0; i < 8; ++i) { y[2 * i] *= 1.f / (1.f + __builtin_amdgcn_exp2f(-LOG2E * bflo(gw[i]))); y[2 * i + 1] *= 1.f / (1.f + __builtin_amdgcn_exp2f(-LOG2E * bfhi(gw[i]))); } }
        store16_bf16(Og + 32 * d0, y); asm volatile("" ::: "memory"); }
}

__device__ __forceinline__ void xattn_unit(Frame F, PP p, int b, int xh, int qblk) {
    F.fresh();
    const int lane = F.lane, wave = F.wave, tid = F.tid, r32 = lane & 31, hi = lane >> 5;
    const float* QS = (const float*)(p->ws + WS_QS);
    LAS unsigned char* Kt = F.lds; LAS unsigned char* Vt = F.lds + 65536;
    const int sr = tid >> 4, sc = (tid & 15) * 8, vst0 = v_st(sr, sc), vst1 = v_st(32 + sr, sc), kws = KSWZ(sr, sc * 2);
    __syncthreads();
    { const bf16* KVB = (const bf16*)(p->ws + WS_KVB); u32x4 kk[4][2], vv[4][2];
#pragma unroll
      for (int t = 0; t < 4; ++t)
#pragma unroll
          for (int rr = 0; rr < 2; ++rr) { const bf16* base = KVB + (size_t)(b * NMEM + 64 * t + sr + 32 * rr) * (2 * XW) + xh * HD + sc;
              kk[t][rr] = *(const GAS u32x4*)base; vv[t][rr] = *(const GAS u32x4*)(base + XW); }
#pragma unroll
      for (int t = 0; t < 4; ++t)
#pragma unroll
          for (int rr = 0; rr < 2; ++rr) { *(LAS u32x4*)(Kt + t * SHM_KV + kws + rr * 32 * 256) = kk[t][rr]; *(LAS u32x4*)(Vt + t * SHM_KV + (rr ? vst1 : vst0)) = vv[t][rr]; } }
    __syncthreads();
    f32x16 o[4] = {}; float lsum = 0.f, m = -1e30f;
    const size_t tok0 = (size_t)b * SEQ + 128 * qblk + 32 * (wave & 3);
    if (wave < 4) {
        bf16x8 qr[8];
#pragma unroll
        for (int d0 = 0; d0 < 8; ++d0) { f32x4 a = {0.f, 0.f, 0.f, 0.f}, c = a;
#pragma unroll
            for (int s = 0; s < QSPLIT; ++s) { const float* qp = QS + ((size_t)s * NTOK + tok0 + r32) * XW + xh * HD + 16 * d0 + 8 * hi; a += *(const GAS f32x4*)qp; c += *(const GAS f32x4*)(qp + 4); }
            qr[d0] = pack8(a * C2, c * C2); }
#pragma unroll 1
        for (int t = 0; t < 4; ++t) { f32x16 p0, p1; qkt(p0, p1, Kt + t * SHM_KV, r32, hi, qr);
#pragma unroll
            for (int r = 0; r < 16; ++r) m = fmaxf(m, fmaxf(p0[r], p1[r])); }
        { auto rr = __builtin_amdgcn_permlane32_swap(__float_as_uint(m), __float_as_uint(m), false, false); m = fmaxf(__uint_as_float(rr[0]), __uint_as_float(rr[1])); }
#pragma unroll 1
        for (int t = 0; t < 4; ++t) { f32x16 p0, p1; qkt(p0, p1, Kt + t * SHM_KV, r32, hi, qr);
#pragma unroll
            for (int r = 0; r < 16; ++r) { p0[r] = __builtin_amdgcn_exp2f(p0[r] - m); p1[r] = __builtin_amdgcn_exp2f(p1[r] - m); lsum += p0[r] + p1[r]; }
            bf16x8 pa0, pa1, pa2, pa3; pack_p(p0, p1, pa0, pa1, pa2, pa3);
            pv_tile(o, (int)(uintptr_t)(Vt + t * SHM_KV) + v_rd_base(lane), pa0, pa1, pa2, pa3); }
        lsum += __shfl_xor(lsum, 32);
    }
    __syncthreads();
    if (wave < 4) {
        LAS float* wsw = (LAS float*)(F.lds + 32768) + wave * 64; LAS float* ost = (LAS float*)(F.lds + wave * OST_WAVE);
        if (hi == 0) wsw[r32] = 1.f / lsum; LDS_WAIT(); asm volatile("" ::: "memory");
        float il[16];
#pragma unroll
        for (int r = 0; r < 16; ++r) il[r] = wsw[crow(r, hi)];
        float v[4][16], ss; o_rows(o, il, ost, lane, v, ss);
        const int row = lane >> 1, half = lane & 1;
        bf16* Og = (bf16*)(p->ws + WS_OX) + (tok0 + row) * XW + xh * HD + 16 * half;
#pragma unroll
        for (int d0 = 0; d0 < 4; ++d0) store16_bf16(Og + 32 * d0, v[d0]);
    }
}

__device__ __forceinline__ void flogit_rows(Frame F, PP p, int row0  ) {
    F.fresh();
    typedef float f32x4v __attribute__((ext_vector_type(4)));
    const bf16* H0 = (const bf16*)(p->ws + WS_H0); const bf16* WfT = (const bf16*)(p->ws + WS_WF);
    const int rt = F.wave >> 2, kq = F.wave & 3, l15 = F.lane & 15, lq = F.lane >> 4;
    const bf16* ap = H0 + (size_t)(row0 + 16 * rt + l15) * DM + kq * 1024 + 8 * lq;
    const bf16* bp = WfT + (size_t)l15 * DM + kq * 1024 + 8 * lq;
    f32x4v acc = {0.f, 0.f, 0.f, 0.f};
#pragma unroll 8
    for (int ks = 0; ks < 32; ++ks) { const bf16x8 a = *(const GAS bf16x8*)(ap + 32 * ks), bb = *(const GAS bf16x8*)(bp + 32 * ks);
        acc = __builtin_amdgcn_mfma_f32_16x16x32_bf16(a, bb, acc, 0, 0, 0); }
    LAS float* red = (LAS float*)F.lds;
    __syncthreads();
#pragma unroll
    for (int i = 0; i < 4; ++i) red[F.wave * 256 + (4 * lq + i) * 16 + l15] = acc[i];
    __syncthreads();
    { const int t = F.tid, rt2 = t >> 8, rc = t & 255; const LAS float* q = red + rt2 * 1024 + rc;
      ((float*)(p->ws + WS_FL))[(size_t)(row0 + 16 * rt2 + (rc >> 4)) * 16 + (rc & 15)] = (q[0] + q[256]) + (q[512] + q[768]); }
}

__device__ __forceinline__ void router_rows(Frame F, PP p, int row0  ) {
    F.fresh();
    typedef float f32x4v __attribute__((ext_vector_type(4)));
    const bf16* H2 = (const bf16*)(p->ws + WS_H2); const bf16* WrT = (const bf16*)(p->ws + WS_WR);
    const int rt = F.wave >> 2, kq = F.wave & 3, l15 = F.lane & 15, lq = F.lane >> 4;
    const bf16* ap = H2 + (size_t)(row0 + 16 * rt + l15) * DM + kq * 1024 + 8 * lq;
    const bf16* bp0 = WrT + (size_t)l15 * DM + kq * 1024 + 8 * lq; const bf16* bp1 = bp0 + (size_t)16 * DM;
    f32x4v acc0 = {0.f, 0.f, 0.f, 0.f}, acc1 = acc0;
#pragma unroll 8
    for (int ks = 0; ks < 32; ++ks) { const bf16x8 a = *(const GAS bf16x8*)(ap + 32 * ks), b0 = *(const GAS bf16x8*)(bp0 + 32 * ks), b1 = *(const GAS bf16x8*)(bp1 + 32 * ks);
        acc0 = __builtin_amdgcn_mfma_f32_16x16x32_bf16(a, b0, acc0, 0, 0, 0); acc1 = __builtin_amdgcn_mfma_f32_16x16x32_bf16(a, b1, acc1, 0, 0, 0); }
    LAS float* red = (LAS float*)F.lds;
    __syncthreads();
#pragma unroll
    for (int i = 0; i < 4; ++i) { red[F.wave * 512 + (4 * lq + i) * 32 + l15] = acc0[i]; red[F.wave * 512 + (4 * lq + i) * 32 + 16 + l15] = acc1[i]; }
    __syncthreads();
    LAS float* lg = red + 4096;
    for (int t = F.tid; t < 1024; t += 512) { const int r = t >> 5, e = t & 31, rt2 = r >> 4; const LAS float* q = red + rt2 * 2048 + (r & 15) * 32 + e;
        lg[r * 33 + e] = (q[0] + q[512]) + (q[1024] + q[1536]) + p->router_b[e]; }
    __syncthreads();
    if (F.tid < 32) { const int r = F.tid; float val[4]; int idx[4]; unsigned used = 0u;
#pragma unroll
        for (int k = 0; k < 4; ++k) { float best = -__builtin_inff(); int bi = 0;
            for (int e = 0; e < 32; ++e) { const float x = lg[r * 33 + e]; if (!((used >> e) & 1u) && x > best) { best = x; bi = e; } }
            val[k] = best; idx[k] = bi; used |= 1u << bi; }
        float w[4], s = 0.f;
#pragma unroll
        for (int k = 0; k < 4; ++k) { w[k] = __builtin_amdgcn_exp2f((val[k] - val[0]) * LOG2E); s += w[k]; }
        const float inv = 1.f / s; const int tok = row0 + r;
        int* LIST = (int*)(p->ws + WS_LIST); float* GATE = (float*)(p->ws + WS_GATE); unsigned* cnt = (unsigned*)(p->ws + WS_CTL) + CW_CNT;
#pragma unroll
        for (int k = 0; k < 4; ++k) { const unsigned pos = atomicAdd(cnt + 64 * idx[k], 1u); LIST[idx[k] * NTOK + pos] = tok * 4 + k; GATE[tok * 4 + k] = w[k] * inv; } }
}

namespace pg8 {
struct MoeSched {
    const char* A; const char* Bt; size_t bstride_e; int lda, ldb, NT, G, c; LAS const int* tab; bool gather;
    __device__ __forceinline__ bool next(int i, Unit& u) const {
        const int TM = __builtin_amdgcn_readfirstlane(tab[64]); const int nwg = NT * TM; const long L = (long)i * G + c; if (L >= nwg) return false;
        const int wgid = xcd_remap((int)L, nwg); const int mtg = wgid / NT; u.pn = wgid - mtg * NT;
        int e = 0;
        for (int k = 1; k < NE; ++k) e += (__builtin_amdgcn_readfirstlane(tab[32 + k]) <= mtg) ? 1 : 0;
        u.e = e; u.pm = mtg - __builtin_amdgcn_readfirstlane(tab[32 + e]); u.aux = i; return true;
    }
    __device__ __forceinline__ int a_off(const Unit& u) const { return gather ? 0 : (BM * (__builtin_amdgcn_readfirstlane(tab[32 + u.e]) + u.pm)) * lda; }
    __device__ __forceinline__ int b_off(const Unit& u) const { return u.e * (int)bstride_e + u.pn * BM * ldb; }
    __device__ __forceinline__ int arow(const Unit& u, int pos) const { return gather ? tab[128 + 256 * u.aux + pos] : pos; }
};
struct EpiUp {
    static constexpr bool PERM = true;
    unsigned char* ACT; const float* b_up; LAS const int* tab;
    __device__ __forceinline__ void operator()(const f32x4 (&acc)[2][2][4][2], const Unit& u, int wr, int wc, int fr, int fq) const {
        const int seg = BM * tab[32 + u.e]; const int row0 = seg + u.pm * BM + wr * 64 + fr, jcol = 128 * u.pn + 32 * wc + 8 * fq;
        const float* bg = b_up + (size_t)u.e * (2 * DE) + jcol; const float* bu = bg + DE;
        const f32x4 bg0 = *(const GAS f32x4*)bg, bg1 = *(const GAS f32x4*)(bg + 4), bu0 = *(const GAS f32x4*)bu, bu1 = *(const GAS f32x4*)(bu + 4);
#pragma unroll
        for (int ai = 0; ai < 2; ++ai)
#pragma unroll
            for (int m = 0; m < 4; ++m) { unsigned char* rowp = ACT + (size_t)(row0 + ai * HALF + m * 16) * DE + jcol; float a[8];
#pragma unroll
                for (int n = 0; n < 2; ++n) { const f32x4 gv = acc[ai][0][m][n] + (n ? bg1 : bg0), uv = acc[ai][1][m][n] + (n ? bu1 : bu0);
#pragma unroll
                    for (int i = 0; i < 4; ++i) { const float g = fminf(gv[i], 7.f), uu = fminf(fmaxf(uv[i], -7.f), 7.f);
                        a[4 * n + i] = (uu + 1.f) * g / (1.f + __builtin_amdgcn_exp2f(-1.702f * LOG2E * g)); } }
                *(u32x2*)rowp = (u32x2){pk4_fp8(a[0] * F8S_ACT, a[1] * F8S_ACT, a[2] * F8S_ACT, a[3] * F8S_ACT), pk4_fp8(a[4] * F8S_ACT, a[5] * F8S_ACT, a[6] * F8S_ACT, a[7] * F8S_ACT)}; }
    }
};
struct EpiDown {
    static constexpr bool PERM = true;
    bf16* Y; const float* b_down; const int* LIST; const float* GATE; LAS const int* tab;
    __device__ __forceinline__ void operator()(const f32x4 (&acc)[2][2][4][2], const Unit& u, int wr, int wc, int fr, int fq) const {
        const int cnt = tab[u.e]; const int col0 = u.pn * BM + wc * 32 + 8 * fq; const float* bd = b_down + (size_t)u.e * DM + col0;
        f32x4 bv[2][2];
#pragma unroll
        for (int bj = 0; bj < 2; ++bj)
#pragma unroll
            for (int n = 0; n < 2; ++n) bv[bj][n] = *(const GAS f32x4*)(bd + bj * HALF + 4 * n);
#pragma unroll
        for (int ai = 0; ai < 2; ++ai)
#pragma unroll
            for (int m = 0; m < 4; ++m) { const int pos = u.pm * BM + ai * HALF + wr * 64 + m * 16 + fr;
                if (pos < cnt) { const int lv = LIST[(size_t)u.e * NTOK + pos]; const float gt = GATE[lv]; bf16* rowp = Y + (size_t)lv * DM + col0;
#pragma unroll
                    for (int bj = 0; bj < 2; ++bj) { const f32x4 v0 = (acc[ai][bj][m][0] + bv[bj][0]) * gt, v1 = (acc[ai][bj][m][1] + bv[bj][1]) * gt;
                        u32x4 w = {cvt_pk_bf16(v0[0], v0[1]), cvt_pk_bf16(v0[2], v0[3]), cvt_pk_bf16(v1[0], v1[1]), cvt_pk_bf16(v1[2], v1[3])};
                        *(u32x4*)(rowp + bj * HALF) = w; } } }
    }
};
}
__device__ __forceinline__ void moe_tables(Frame F, PP p, int NT, bool gather) {
    F.fresh();
    LAS int* tab = (LAS int*)(F.lds + LDSX_OFF); const unsigned* cnt = (const unsigned*)(p->ws + WS_CTL) + CW_CNT;
    __syncthreads();
    if (F.tid < NE) { unsigned c = __hip_atomic_load(cnt + 64 * F.tid, RLX_AGENT); tab[F.tid] = (int)(c > (unsigned)NTOK ? (unsigned)NTOK : c); }
    __syncthreads();
    if (F.tid == 0) { int s = 0; for (int e = 0; e < NE; ++e) { tab[32 + e] = s; s += (tab[e] + 255) >> 8; } tab[64] = s; }
    __syncthreads();
    if (gather) {
        const int TM = tab[64], nwg = NT * TM; const int* LIST = (const int*)(p->ws + WS_LIST);
        for (int i = 0; i < 10; ++i) { const long L = (long)i * F.G + (int)blockIdx.x; if (L >= nwg) break;
            const int wgid = pg8::xcd_remap((int)L, nwg), mtg = wgid / NT; int e = 0; for (int k = 1; k < NE; ++k) e += (tab[32 + k] <= mtg) ? 1 : 0;
            const int pm = mtg - tab[32 + e];
            if (F.tid < 256) { const int pos = pm * 256 + F.tid; tab[128 + 256 * i + F.tid] = (pos < tab[e]) ? (LIST[(size_t)e * NTOK + pos] >> 2) : 0; } }
        __syncthreads();
    }
}

constexpr int I_A = 64 * 128, I_B = 64 * 96, I_C = 64 * 64, I_D = 64 * 8, I_E = 64 * 16, I_F = 8 * 64, I_H = 32 * 64 * 32, I_I = 32 * 16 * 64;
constexpr int NITEMS = I_A + I_B + I_C + I_D + I_E + I_F + I_H + I_I, NITEMS_DENSE = NITEMS - I_H - I_I;
struct TrItem { const float* W; bf16* WT; int ldw, k0, scol, ldk, drow, f8; };
__device__ __forceinline__ void tr_decode(int r, PP p, TrItem& t) {
    unsigned char* ws = p->ws; t.f8 = 0;
    if (r < I_A) { const int kb = r / 128, nb = r % 128; t.W = p->w_in; t.ldw = N_IN_SRC; t.k0 = 64 * kb; t.scol = 64 * nb; t.WT = (bf16*)(ws + WS_WIN); t.ldk = DM; t.drow = 64 * nb; return; } r -= I_A;
    if (r < I_B) { const int kb = r / 96, nb = r % 96; t.W = p->w_in; t.ldw = N_IN_SRC; t.k0 = 64 * kb; t.scol = 8208 + 64 * nb; t.WT = (bf16*)(ws + WS_WIN); t.ldk = DM; t.drow = 8192 + 64 * nb; return; } r -= I_B;
    if (r < I_C) { const int kb = r / 64, nb = r % 64; t.W = p->w_out; t.ldw = DM; t.k0 = 64 * kb; t.scol = 64 * nb; t.WT = (bf16*)(ws + WS_WOUT); t.ldk = DM; t.drow = 64 * nb; return; } r -= I_C;
    if (r < I_D) { const int kb = r / 8, nb = r % 8; t.W = p->xa_wq; t.ldw = XW; t.k0 = 64 * kb; t.scol = 64 * nb; t.WT = (bf16*)(ws + WS_WQ); t.ldk = DM; t.drow = 64 * nb; return; } r -= I_D;
    if (r < I_E) { const int kb = r / 16, nb = r % 16; t.W = p->xa_wkv; t.ldw = 2 * XW; t.k0 = 64 * kb; t.scol = 64 * nb; t.WT = (bf16*)(ws + WS_WKV); t.ldk = DM; t.drow = 64 * nb; return; } r -= I_E;
    if (r < I_F) { const int kb = r / 64, nb = r % 64; t.W = p->xa_wo; t.ldw = DM; t.k0 = 64 * kb; t.scol = 64 * nb; t.WT = (bf16*)(ws + WS_WO); t.ldk = XW; t.drow = 64 * nb; return; } r -= I_F;
    if (r < I_H) { const int e = r / 2048, q = r % 2048, kb = q / 32, nb = q % 32, tt = nb >> 2, bj = (nb >> 1) & 1, qq = nb & 1;
        t.W = p->w_up + (size_t)e * DM * (2 * DE); t.ldw = 2 * DE; t.k0 = 64 * kb; t.scol = (bj ? DE : 0) + 128 * tt + 64 * qq; t.WT = (bf16*)(ws + WS_WUP + (size_t)e * (2 * DE) * DM); t.ldk = DM; t.drow = 64 * nb; t.f8 = 1; return; } r -= I_H;
    { const int e = r / 1024, q = r % 1024, kb = q / 64, nb = q % 64; t.W = p->w_down + (size_t)e * DE * DM; t.ldw = DM; t.k0 = 64 * kb; t.scol = 64 * nb; t.WT = (bf16*)(ws + WS_WDN + (size_t)e * DM * DE); t.ldk = DE; t.drow = 64 * nb; t.f8 = 1; }
}
__device__ __forceinline__ void tr_run(PP p, int it0, int it1, int wslot, int stride, LAS unsigned char* scr, int lane) {
    f32x4 v[16]; TrItem t; int it = it0 + wslot;
    if (it < it1) { tr_decode(it, p, t); tr64_load(v, t.W, t.ldw, t.k0, t.scol, lane); }
    while (it < it1) {
        f32x4 c[16];
#pragma unroll
        for (int i = 0; i < 16; ++i) c[i] = v[i];
        const TrItem tc = t;
        it += stride;
        if (it < it1) { tr_decode(it, p, t); tr64_load(v, t.W, t.ldw, t.k0, t.scol, lane); }
        if (tc.f8) tr64_finish_fp8(c, (unsigned char*)tc.WT, tc.ldk, tc.k0, tc.drow, scr, lane); else tr64_finish(c, tc.WT, tc.ldk, tc.k0, tc.drow, scr, lane);
    }
}

constexpr int N_PHASES = 12;
__global__ void __launch_bounds__(512, 2) fwd_kernel(Params p_arg) {
    (void)p_arg; PP p = (PP)__builtin_amdgcn_kernarg_segment_ptr();
    extern __shared__ __attribute__((aligned(16))) unsigned char lds_raw[];
    Frame F;
    F.lds = (LAS unsigned char*)lds_raw; F.MISC = (volatile LAS unsigned*)(F.lds + MISC_OFF);
    F.tid = threadIdx.x; F.lane = F.tid & 63; F.wave = __builtin_amdgcn_readfirstlane(F.tid >> 6);
    F.G = gridDim.x; { const int bx = blockIdx.x; F.vcu = (F.G % 8 == 0) ? (bx % 8) * (F.G / 8) + bx / 8 : bx; }
    F.ctl = (gu32*)(p->ws + WS_CTL);
    for (int u = F.tid; u < (LDS_BYTES - MISC_OFF) / 4; u += 512) ((LAS unsigned*)(F.lds + MISC_OFF))[u] = 0u;
    __syncthreads();
    XcdBarrier bar; bar.bar = (unsigned*)(F.ctl + CW_BAR); bar.x = 0; bar.st = nullptr;
    if (!MK_PER_PHASE) bar = xcd_barrier_post((unsigned*)(F.ctl + CW_BAR), F.MISC + 8);
    const int lo = p->ph_lo, hi = p->ph_hi;
#ifndef PHMASK
#define PHMASK 0xFFF
#endif
#define IN(k) (((PHMASK >> (k)) & 1) && lo <= (k) && (k) < hi)
#define GRID_BAR(k) do { if (IN(k) && IN((k) + 1)) xcd_barrier(bar); } while (0)
    bf16* const WIN = (bf16*)(p->ws + WS_WIN); bf16* const WOUT = (bf16*)(p->ws + WS_WOUT); bf16* const WQ = (bf16*)(p->ws + WS_WQ); bf16* const WKV = (bf16*)(p->ws + WS_WKV);
    bf16* const WO = (bf16*)(p->ws + WS_WO); bf16* const WF = (bf16*)(p->ws + WS_WF); bf16* const WR = (bf16*)(p->ws + WS_WR); bf16* const WUP = (bf16*)(p->ws + WS_WUP); bf16* const WDN = (bf16*)(p->ws + WS_WDN);
    bf16* const H0 = (bf16*)(p->ws + WS_H0); bf16* const MEMN = (bf16*)(p->ws + WS_MEMN); bf16* const PB = (bf16*)(p->ws + WS_P); bf16* const OB = (bf16*)(p->ws + WS_O);
    bf16* const RB = (bf16*)(p->ws + WS_R); bf16* const H1 = (bf16*)(p->ws + WS_H1); bf16* const H2 = (bf16*)(p->ws + WS_H2); bf16* const OX = (bf16*)(p->ws + WS_OX);
    bf16* const ACT = (bf16*)(p->ws + WS_ACT); bf16* const YB = (bf16*)(p->ws + WS_Y);
    const int gw = F.vcu * 8 + F.wave, NGW = F.G * 8;

    for (int rep_ = 0; rep_ < ((PROBE_REP == 0) ? 2 : 1); ++rep_) { if (rep_) xcd_barrier(bar);
    if (IN(0)) {
        F.fresh(); P_FRESH(p);
        LAS unsigned char* scr = F.lds + F.wave * TR_WAVE_BYTES;
        tr_run(p, 0, NITEMS_DENSE, gw, NGW, scr, F.lane);
        { LAS float* scr32 = (LAS float*)scr;
          for (int it = gw; it < 64; it += NGW) tr_item(p->router_w, NE, 64 * it, 0, WR, DM, 0, scr32, F.lane); }
        for (int idx = (int)blockIdx.x * 512 + F.tid; idx < 16 * DM; idx += F.G * 512) { const int k = idx >> 4, n = idx & 15; WF[(size_t)n * DM + k] = (bf16)f2bf(p->w_in[(size_t)k * N_IN_SRC + 8192 + n]); }
        ln_rows_f32(p->x, p->ln_in_g, p->ln_in_b, H0, gw, NGW, NTOK, F.lane);
        ln_rows_f32(p->mem, p->mem_ln_g, p->mem_ln_b, MEMN, gw, NGW, NB * NMEM, F.lane);
    }
    }
    GRID_BAR(0);

    for (int rep_ = 0; rep_ < ((PROBE_REP == 1) ? 2 : 1); ++rep_) { if (rep_) xcd_barrier(bar);
    if (IN(1)) {
        F.fresh(); P_FRESH(p);
        pg8::DenseSched S; S.init(H0, WIN, DM * 2, DM * 2, NTOK, NP, F.G, (int)blockIdx.x);
        pg8::EpiBf16 E{PB, NP};
        const int slot = ((int)blockIdx.x >> 3) & 7;
        S.ib = 0; S.ie = slot;
        pg8::gemm_phase<pg8::EpiBf16, pg8::DenseSched, true, false>(F.lds, DM * 2, DM * 2, DM * 2, S, E);
        __syncthreads();
        tr_run(p, NITEMS_DENSE, NITEMS, gw, NGW, F.lds + F.wave * TR_WAVE_BYTES, F.lane);
        __syncthreads();
        S.ib = slot; S.ie = 1 << 30;
        pg8::gemm_phase<pg8::EpiBf16, pg8::DenseSched, true, false>(F.lds, DM * 2, DM * 2, DM * 2, S, E);
        for (int rb = blockIdx.x; rb < NTOK / 32; rb += F.G) flogit_rows(F, p, 32 * rb);
    }
    }
    GRID_BAR(1);

    for (int rep_ = 0; rep_ < ((PROBE_REP == 2) ? 2 : 1); ++rep_) { if (rep_) xcd_barrier(bar);
    if (IN(2)) {
        F.fresh(); P_FRESH(p);
        for (int pid = F.vcu; pid < 256; pid += F.G) {
            const int bh = pid >> 2, b = bh >> 4, h = bh & 15, q0 = pid & 3;
            fox_tables(F, p, b, h);
#pragma unroll 1
            for (int rep = 0; rep < 2; ++rep) attn_unit<0>(F, p, b, h, rep ? q0 : 7 - q0);
#pragma unroll 1
            for (int rep = 0; rep < 2; ++rep) attn_unit<1>(F, p, b, h, rep ? q0 : 7 - q0);
        }
    }
    }
    GRID_BAR(2);

    for (int rep_ = 0; rep_ < ((PROBE_REP == 3) ? 2 : 1); ++rep_) { if (rep_) xcd_barrier(bar);
    if (IN(3)) {
        F.fresh(); P_FRESH(p);
        pg8::DenseSched S; S.init(OB, WOUT, DM * 2, DM * 2, NTOK, DM, F.G, (int)blockIdx.x);
        pg8::EpiRes E{RB, H0, DM, DN_ALPHA};
        pg8::gemm_phase<pg8::EpiRes, pg8::DenseSched, true, false>(F.lds, DM * 2, DM * 2, DM * 2, S, E);
    }
    }
    GRID_BAR(3);

    for (int rep_ = 0; rep_ < ((PROBE_REP == 4) ? 2 : 1); ++rep_) { if (rep_) xcd_barrier(bar);
    if (IN(4)) {
        F.fresh(); P_FRESH(p);
        const int nkv = (F.G >= 128) ? 64 : 0;
        if ((int)blockIdx.x < nkv || nkv == 0) {
            for (int c = blockIdx.x; c < 64; c += (nkv ? 64 : F.G)) {
                pg8::SplitKSched S{(const char*)MEMN, (const char*)WKV, DM * 2, DM * 2, 4, 4, QSPLIT, QKS, c};
                pg8::EpiSlab E{(float*)(p->ws + WS_KVS), 2 * XW, (size_t)NB * NMEM * 2 * XW};
                pg8::gemm_phase<pg8::EpiSlab, pg8::SplitKSched, false, false>(F.lds, QKS * 2, DM * 2, DM * 2, S, E);
                if (nkv) break;
            }
        }
        if ((int)blockIdx.x >= nkv) { const int nw = (F.G - nkv) * 8, w0 = ((int)blockIdx.x - nkv) * 8 + F.wave;
            ln_rows_bf16(RB, p->ln_mix_g, p->ln_mix_b, H1, w0, nw, NTOK, F.lane); }
    }
    }
    GRID_BAR(4);

    for (int rep_ = 0; rep_ < ((PROBE_REP == 5) ? 2 : 1); ++rep_) { if (rep_) xcd_barrier(bar);
    if (IN(5)) {
        F.fresh(); P_FRESH(p);
        for (int c = blockIdx.x; c < 256; c += F.G) {
            pg8::SplitKSched S{(const char*)H1, (const char*)WQ, DM * 2, DM * 2, NTOK / 256, 2, QSPLIT, QKS, c};
            pg8::EpiSlab E{(float*)(p->ws + WS_QS), XW, (size_t)NTOK * XW};
            pg8::gemm_phase<pg8::EpiSlab, pg8::SplitKSched, false, false>(F.lds, QKS * 2, DM * 2, DM * 2, S, E);
        }
        { const float* KVS = (const float*)(p->ws + WS_KVS); bf16* KVB = (bf16*)(p->ws + WS_KVB);
          for (int i = (int)blockIdx.x * 512 + F.tid; i < NB * NMEM * 2 * XW / 4; i += F.G * 512) { f32x4 a = {0.f, 0.f, 0.f, 0.f};
#pragma unroll
              for (int s = 0; s < QSPLIT; ++s) a += ((const GAS f32x4*)(KVS + (size_t)s * NB * NMEM * 2 * XW))[i];
              ((GAS u32x2*)KVB)[i] = (u32x2){cvt_pk_bf16(a[0], a[1]), cvt_pk_bf16(a[2], a[3])}; } }
    }
    }
    GRID_BAR(5);

    for (int rep_ = 0; rep_ < ((PROBE_REP == 6) ? 2 : 1); ++rep_) { if (rep_) xcd_barrier(bar);
    if (IN(6)) {
        F.fresh(); P_FRESH(p);
        for (int u = F.vcu; u < 256; u += F.G) xattn_unit(F, p, u >> 6, (u >> 4) & 3, u & 15);
    }
    }
    GRID_BAR(6);

    for (int rep_ = 0; rep_ < ((PROBE_REP == 7) ? 2 : 1); ++rep_) { if (rep_) xcd_barrier(bar);
    if (IN(7)) {
        F.fresh(); P_FRESH(p);
        pg8::DenseSched S; S.init(OX, WO, XW * 2, XW * 2, NTOK, DM, F.G, (int)blockIdx.x);
        pg8::EpiRes E{RB, H1, DM, DN_ALPHA};
        pg8::gemm_phase<pg8::EpiRes, pg8::DenseSched, true, false>(F.lds, XW * 2, XW * 2, XW * 2, S, E);
    }
    }
    GRID_BAR(7);

    for (int rep_ = 0; rep_ < ((PROBE_REP == 8) ? 2 : 1); ++rep_) { if (rep_) xcd_barrier(bar);
    if (IN(8)) {
        F.fresh(); P_FRESH(p);
        for (int rb = blockIdx.x; rb < NTOK / 32; rb += F.G) {
            ln_rows_bf16(RB, p->ln_xa_g, p->ln_xa_b, H2, 32 * rb + 4 * F.wave, 1, 32 * rb + 4 * F.wave + 4, F.lane, p->ws + WS_H2F8);
            VM_WAIT(); __syncthreads();
            if (F.wave == 0) { __builtin_amdgcn_fence(__ATOMIC_RELEASE, "agent"); __builtin_amdgcn_fence(__ATOMIC_ACQUIRE, "agent"); VM_WAIT(); }
            __syncthreads();
            router_rows(F, p, 32 * rb);
        }
    }
    }
    GRID_BAR(8);

    for (int rep_ = 0; rep_ < ((PROBE_REP == 9) ? 2 : 1); ++rep_) { if (rep_) xcd_barrier(bar);
    if (IN(9)) {
        F.fresh(); P_FRESH(p);
        moe_tables(F, p, 8, true);
        LAS const int* tab = (LAS const int*)(F.lds + LDSX_OFF);
        pg8::MoeSched S{(const char*)(p->ws + WS_H2F8), (const char*)WUP, (size_t)(2 * DE) * DM, DM, DM, 8, F.G, (int)blockIdx.x, tab, true};
        pg8::EpiUp E{(unsigned char*)ACT, p->b_up, tab};
        pg8::gemm_phase<pg8::EpiUp, pg8::MoeSched, true, true, true>(F.lds, DM, DM, DM, S, E, E8_H2, E8_W);
    }
    }
    GRID_BAR(9);

    for (int rep_ = 0; rep_ < ((PROBE_REP == 10) ? 2 : 1); ++rep_) { if (rep_) xcd_barrier(bar);
    if (IN(10)) {
        F.fresh(); P_FRESH(p);
        moe_tables(F, p, 16, false);
        LAS const int* tab = (LAS const int*)(F.lds + LDSX_OFF);
        pg8::MoeSched S{(const char*)ACT, (const char*)WDN, (size_t)DM * DE, DE, DE, 16, F.G, (int)blockIdx.x, tab, false};
        pg8::EpiDown E{YB, p->b_down, (const int*)(p->ws + WS_LIST), (const float*)(p->ws + WS_GATE), tab};
        pg8::gemm_phase<pg8::EpiDown, pg8::MoeSched, true, false, true>(F.lds, DE, DE, DE, S, E, E8_ACT, E8_W);
    }
    }
    GRID_BAR(10);

    for (int rep_ = 0; rep_ < ((PROBE_REP == 11) ? 2 : 1); ++rep_) { if (rep_) xcd_barrier(bar);
    if (IN(11)) {
        F.fresh(); P_FRESH(p);
        const unsigned bad = __hip_atomic_load(F.ctl + CW_BAR + XB_TMO, RLX_AGENT);
        const int half = F.wave & 1, rs = F.wave >> 1; LAS float* st = (LAS float*)F.lds;
        const int nsteps = (NTOK / 4 + F.G - 1) / F.G;
        u32x2 nh[8], ny[4][8];
#define P11_LOAD(m) do { const GAS u32x2* hp_ = (const GAS u32x2*)(H2 + (size_t)(m) * DM + half * 2048) + F.lane; \
            _Pragma("unroll") for (int j = 0; j < 8; ++j) nh[j] = hp_[64 * j]; \
            _Pragma("unroll") for (int k = 0; k < 4; ++k) { const GAS u32x2* yp_ = (const GAS u32x2*)(YB + ((size_t)(m) * 4 + k) * DM + half * 2048) + F.lane; \
                _Pragma("unroll") for (int j = 0; j < 8; ++j) ny[k][j] = yp_[64 * j]; } } while (0)
        int grp = F.vcu;
        if (grp * 4 < NTOK) P11_LOAD(grp * 4 + rs);
        for (int it = 0; it < nsteps; ++it) {
            const int m = grp * 4 + rs; const bool live = grp * 4 < NTOK;
            f32x4 v[8]; float s1 = 0.f, s2 = 0.f;
#pragma unroll
            for (int j = 0; j < 8; ++j) { f32x4 a = {DN_ALPHA * bflo(nh[j].x), DN_ALPHA * bfhi(nh[j].x), DN_ALPHA * bflo(nh[j].y), DN_ALPHA * bfhi(nh[j].y)};
#pragma unroll
                for (int k = 0; k < 4; ++k) { a[0] += bflo(ny[k][j].x); a[1] += bfhi(ny[k][j].x); a[2] += bflo(ny[k][j].y); a[3] += bfhi(ny[k][j].y); }
                v[j] = a; s1 += (a[0] + a[1]) + (a[2] + a[3]); s2 += (a[0] * a[0] + a[1] * a[1]) + (a[2] * a[2] + a[3] * a[3]); }
            grp += F.G;
            if (grp * 4 < NTOK) P11_LOAD(grp * 4 + rs);
            s1 = wave_sum(s1); s2 = wave_sum(s2);
            if (F.lane == 0) { st[(it & 1) * 16 + F.wave * 2] = s1; st[(it & 1) * 16 + F.wave * 2 + 1] = s2; }
            __syncthreads();
            const float t1 = s1 + st[(it & 1) * 16 + (F.wave ^ 1) * 2], t2 = s2 + st[(it & 1) * 16 + (F.wave ^ 1) * 2 + 1];
            const float mean = t1 * (1.f / DM); const float var = fmaxf(t2 * (1.f / DM) - mean * mean, 0.f); const float rstd = 1.f / sqrtf(var + LN_EPS);
            if (live) { const GAS f32x4* g4 = (const GAS f32x4*)(p->ln_moe_g + half * 2048) + F.lane; const GAS f32x4* b4 = (const GAS f32x4*)(p->ln_moe_b + half * 2048) + F.lane;
                GAS f32x4* o4 = (GAS f32x4*)(p->out + (size_t)m * DM + half * 2048) + F.lane;
#pragma unroll
                for (int j = 0; j < 8; ++j) { f32x4 y = (v[j] - mean) * rstd * g4[64 * j] + b4[64 * j]; if (bad) y[0] = __builtin_nanf(""); o4[64 * j] = y; } }
        }
#undef P11_LOAD
    }
    }
#undef IN
#undef GRID_BAR
}

extern "C" void kernel_launch(void* const* d_in, const int* in_sizes, int n_in, void* d_out, int out_size, void* d_ws, size_t ws_size, hipStream_t stream) {
    static int grid = 0;
    if (grid == 0) {
        if (n_in != 27 || out_size != NTOK * DM || ws_size < WS_END) { fprintf(stderr, "kernel_launch: unexpected problem shape (n_in %d, out %d, ws %zu)\n", n_in, out_size, ws_size); grid = -1; return; }
        int dev = 0, cus = 0, per_cu = 0;
        if (hipGetDevice(&dev) != hipSuccess || hipDeviceGetAttribute(&cus, hipDeviceAttributeMultiprocessorCount, dev) != hipSuccess) { grid = -1; return; }
        if (hipFuncSetAttribute((const void*)fwd_kernel, hipFuncAttributeMaxDynamicSharedMemorySize, LDS_BYTES) != hipSuccess) { fprintf(stderr, "kernel_launch: hipFuncSetAttribute failed\n"); grid = -1; return; }
        if (hipOccupancyMaxActiveBlocksPerMultiprocessor(&per_cu, (const void*)fwd_kernel, 512, LDS_BYTES) != hipSuccess || per_cu < 1) fprintf(stderr, "kernel_launch: occupancy query reports %d blocks per CU\n", per_cu);
        (void)hipGetLastError();
        grid = cus;
    }
    if (grid < 0) return;
    (void)hipMemsetAsync((char*)d_ws + WS_CTL, 0, CTL_ZERO_BYTES, stream);
    Params p{};
    const float** pp = (const float**)&p;
    for (int i = 0; i < 27; ++i) pp[i] = (const float*)d_in[i];
    p.out = (float*)d_out; p.ws = (unsigned char*)d_ws;
#if MK_PER_PHASE
    for (int k = 0; k < N_PHASES; ++k) { p.ph_lo = k; p.ph_hi = k + 1; hipLaunchKernelGGL(fwd_kernel, dim3(grid), dim3(512), LDS_BYTES, stream, p); }
#else
    p.ph_lo = 0; p.ph_hi = N_PHASES;
    hipLaunchKernelGGL(fwd_kernel, dim3(grid), dim3(512), LDS_BYTES, stream, p);
#endif
}
```
